# Optimizing an MI355X kernel written in HIP

```python
import math
import jax, jax.numpy as jnp
from jax import lax
import numpy as np

D_MODEL = 1024
BATCH = 8
SEQ = 2048
DEPTH = 4
DEC_BATCH = 128
DEC_SEQ = 8
PAST_LEN = 2048
PAGE_SIZE = 128

N_A = (DEPTH + 1) // 2
N_C = DEPTH // 2
HD = 64
H_A = (D_MODEL // 2) // HD
KVH = 2
HPG = H_A // KVH
L_CMP = 32
L_SEL = 64
N_SEL = 8
WINDOW = 512
ROPE_THETA = 10000.0
Q_BLOCK = 128
FORCE_BONUS = 1.0e4
NEG_INF = -1.0e30
TINY = 1.0e-30
C_B = D_MODEL // 2
CONV_W = 31
D_C = D_MODEL
POOL_WINDOWS = (2, 4, 8, 16)
N_POOL_GROUPS = 4
G_C = D_C // N_POOL_GROUPS
POOL_HIST = max(POOL_WINDOWS) - 1
D_FF = int(math.ceil(8 * D_MODEL / 3 / 256)) * 256
ALPHA = (2 * DEPTH) ** 0.25
BETA = (8 * DEPTH) ** -0.25
Q_COLS = H_A * HD
KV_COLS = KVH * HD
GATE_COLS = 3 * H_A
IN_A = Q_COLS + 6 * KV_COLS + GATE_COLS + 2 * C_B
OUT_A = Q_COLS + C_B

kernel_name = 'nsa_conformer_pool_deepnorm_step'


def _layer_norm(x, g, b, eps=1e-5):
    xf = x.astype(jnp.float32)
    mu = jnp.mean(xf, -1, keepdims=True)
    var = jnp.mean(jnp.square(xf - mu), -1, keepdims=True)
    return ((xf - mu) * lax.rsqrt(var + eps) * g + b).astype(x.dtype)


def _rope(x, pos):
    half = HD // 2
    inv = ROPE_THETA ** (-jnp.arange(half, dtype=jnp.float32) / half)
    ang = pos.astype(jnp.float32)[:, None] * inv[None, :]
    cos = jnp.cos(ang)[None, :, None, :]
    sin = jnp.sin(ang)[None, :, None, :]
    xf = x.astype(jnp.float32)
    x1, x2 = xf[..., :half], xf[..., half:]
    return jnp.concatenate([x1 * cos - x2 * sin, x2 * cos + x1 * sin], -1).astype(x.dtype)


def _masked_softmax(s, mask, axes):
    s = jnp.where(mask, s.astype(jnp.float32), NEG_INF)
    m = jnp.max(s, axis=axes, keepdims=True)
    e = jnp.where(mask, jnp.exp(s - m), 0.0)
    return e / jnp.maximum(jnp.sum(e, axis=axes, keepdims=True), TINY)


def _last_rows(a, n):
    if a.shape[1] >= n:
        return a[:, a.shape[1] - n:]
    pad = [(0, 0)] * a.ndim
    pad[1] = (n - a.shape[1], 0)
    return jnp.pad(a, pad)


def _compress(k, w, pe):
    B, L = k.shape[:2]
    nc = L // L_CMP
    kb = k[:, :nc * L_CMP].reshape(B, nc, L_CMP, KVH, HD) + pe[None, None, :, None, :]
    return jnp.einsum('bnpgd,pde->bnge', kb, w)


def _nsa_attend(q, kc, vc, ks, vs, kw, vw, gates, qpos0, kwpos0):
    B, Sq = q.shape[:2]
    L = ks.shape[1]
    nc = kc.shape[1]
    ns = -(-L // L_SEL)
    n_top = min(N_SEL, ns)
    pad = ns * L_SEL - L
    ks_b = jnp.pad(ks, ((0, 0), (0, pad), (0, 0), (0, 0))).reshape(B, ns, L_SEL, KVH, HD).transpose(0, 3, 1, 2, 4)
    vs_b = jnp.pad(vs, ((0, 0), (0, pad), (0, 0), (0, 0))).reshape(B, ns, L_SEL, KVH, HD).transpose(0, 3, 1, 2, 4)
    kw_p = jnp.pad(kw, ((0, 0), (WINDOW, 0), (0, 0), (0, 0)))
    vw_p = jnp.pad(vw, ((0, 0), (WINDOW, 0), (0, 0), (0, 0)))
    qb = Q_BLOCK if Sq % Q_BLOCK == 0 else Sq
    nb = Sq // qb
    span = WINDOW + qb - 1
    q_blk = q.reshape(B, nb, qb, KVH, HPG, HD).transpose(1, 0, 2, 3, 4, 5)
    g_blk = gates.reshape(B, nb, qb, KVH, HPG, 3).transpose(1, 0, 2, 3, 4, 5)
    cmp_end = jnp.arange(nc, dtype=jnp.int32) * L_CMP + (L_CMP - 1)
    blk_ids = jnp.arange(ns, dtype=jnp.int32)
    b_idx = jnp.arange(B)[:, None, None, None]
    g_idx = jnp.arange(KVH)[None, None, :, None]
    scale = HD ** -0.5

    def block(args):
        qi, gt, i = args
        t = qpos0 + i * qb + jnp.arange(qb, dtype=jnp.int32)
        s_c = jnp.einsum('bqgrd,bngd->bqgrn', qi, kc) * scale
        m_c = (cmp_end[None, :] <= t[:, None])[None, :, None, None, :]
        p_c = _masked_softmax(s_c, m_c, (-1,))
        o_c = jnp.einsum('bqgrn,bngd->bqgrd', p_c.astype(vc.dtype), vc)
        imp = jnp.pad(jnp.sum(p_c, axis=3), ((0, 0), (0, 0), (0, 0), (0, ns * (L_SEL // L_CMP) - nc)))
        imp = imp.reshape(B, qb, KVH, ns, L_SEL // L_CMP).sum(-1)
        cur = (t // L_SEL)[:, None]
        forced = (blk_ids[None] == 0) | (blk_ids[None] == cur) | (blk_ids[None] == cur - 1)
        valid = blk_ids[None] * L_SEL <= t[:, None]
        score = jnp.where(valid[None, :, None, :], imp + jnp.where(forced, FORCE_BONUS, 0.0)[None, :, None, :], -FORCE_BONUS)
        _, idx = lax.top_k(score, n_top)
        k_sel = ks_b[b_idx, g_idx, idx]
        v_sel = vs_b[b_idx, g_idx, idx]
        s_s = jnp.einsum('bqgrd,bqgksd->bqgrks', qi, k_sel) * scale
        kpos = idx[..., None] * L_SEL + jnp.arange(L_SEL, dtype=jnp.int32)
        m_s = (kpos <= t[None, :, None, None, None])[:, :, :, None]
        p_s = _masked_softmax(s_s, m_s, (-2, -1))
        o_s = jnp.einsum('bqgrks,bqgksd->bqgrd', p_s.astype(v_sel.dtype), v_sel)
        start = qpos0 + i * qb + 1 - kwpos0
        k_w = lax.dynamic_slice_in_dim(kw_p, start, span, axis=1)
        v_w = lax.dynamic_slice_in_dim(vw_p, start, span, axis=1)
        wpos = (kwpos0 - WINDOW) + start + jnp.arange(span, dtype=jnp.int32)
        m_w = ((wpos[None] >= kwpos0) & (wpos[None] <= t[:, None]) & (wpos[None] > t[:, None] - WINDOW))[None, :, None, None, :]
        s_w = jnp.einsum('bqgrd,bkgd->bqgrk', qi, k_w) * scale
        p_w = _masked_softmax(s_w, m_w, (-1,))
        o_w = jnp.einsum('bqgrk,bkgd->bqgrd', p_w.astype(v_w.dtype), v_w)
        return gt[..., 0:1] * o_c + gt[..., 1:2] * o_s + gt[..., 2:3] * o_w

    o = lax.map(block, (q_blk, g_blk, jnp.arange(nb, dtype=jnp.int32)))
    return o.transpose(1, 0, 2, 3, 4, 5).reshape(B, Sq, H_A * HD)


def _nsa_conv_mixer(x, pos0, wb, past_kv, win_past, conv_past, w_in, w_ck, pe_ck, w_cv, pe_cv,
                    conv_w, conv_b, cln_g, cln_b, w_out):
    B, S, _ = x.shape
    h = x @ w_in
    cuts = [Q_COLS + i * KV_COLS for i in range(7)] + [Q_COLS + 6 * KV_COLS + GATE_COLS,
                                                        Q_COLS + 6 * KV_COLS + GATE_COLS + C_B]
    q, kc, vc, ks, vs, kw, vw, gl, ga, gb = jnp.split(h, cuts, axis=-1)
    pos = pos0 + jnp.arange(S, dtype=jnp.int32)
    q = _rope(q.reshape(B, S, H_A, HD), pos)
    ks = _rope(ks.reshape(B, S, KVH, HD), pos)
    kw = _rope(kw.reshape(B, S, KVH, HD), pos)
    kv_rows = jnp.stack([kc.reshape(B, S, KVH, HD), vc.reshape(B, S, KVH, HD), ks,
                         vs.reshape(B, S, KVH, HD)], axis=2)
    kv_all = kv_rows if past_kv is None else jnp.concatenate([past_kv, kv_rows], axis=1)
    k_cmp = _compress(kv_all[:, :, 0], w_ck, pe_ck)
    v_cmp = _compress(kv_all[:, :, 1], w_cv, pe_cv)
    k_cmp = _rope(k_cmp, jnp.arange(k_cmp.shape[1], dtype=jnp.int32) * L_CMP + (L_CMP - 1))
    win_rows = jnp.stack([kw, vw.reshape(B, S, KVH, HD)], axis=2)
    if win_past is None:
        win_all, kwpos0 = win_rows, pos0
    else:
        win_all, kwpos0 = jnp.concatenate([win_past, win_rows], axis=1), pos0 - win_past.shape[1]
    gates = jax.nn.sigmoid(gl.reshape(B, S, H_A, 3))
    o_a = _nsa_attend(q, k_cmp, v_cmp, kv_all[:, :, 2], kv_all[:, :, 3],
                      win_all[:, :, 0], win_all[:, :, 1], gates, pos0, kwpos0)
    u = ga * jax.nn.sigmoid(gb)
    hist = jnp.zeros((B, CONV_W - 1, C_B), u.dtype) if conv_past is None else conv_past
    ue = jnp.concatenate([hist, u], axis=1)
    c = lax.conv_general_dilated(ue, conv_w[:, None, :].astype(ue.dtype), (1,), 'VALID',
                                 dimension_numbers=('NWC', 'WIO', 'NWC'), feature_group_count=C_B) + conv_b
    c = jax.nn.silu(_layer_norm(c, cln_g, cln_b))
    out = jnp.concatenate([o_a, c], axis=-1) @ w_out
    return out, kv_rows, _last_rows(win_all, wb), ue[:, ue.shape[1] - (CONV_W - 1):]


def _pool_mixer(x, pos0, pool_past, w_in, w_grp, scale, w_out):
    B, S, _ = x.shape
    u = x @ w_in
    hist = jnp.zeros((B, POOL_HIST, D_C), u.dtype) if pool_past is None else pool_past
    ue = jnp.concatenate([hist, u], axis=1)
    cs = jnp.cumsum(ue.astype(jnp.float32), axis=1)
    cs = jnp.concatenate([jnp.zeros((B, 1, D_C), jnp.float32), cs], axis=1)
    pos = pos0 + jnp.arange(S, dtype=jnp.int32)
    upper = cs[:, POOL_HIST + 1:]
    means = []
    for g, w in enumerate(POOL_WINDOWS):
        lo = POOL_HIST + 1 - w
        sl = slice(g * G_C, (g + 1) * G_C)
        cnt = jnp.minimum(pos + 1, w).astype(jnp.float32)[None, :, None]
        means.append((upper[:, :, sl] - cs[:, lo:lo + S, sl]) / cnt)
    d = jnp.concatenate(means, axis=-1) - u.astype(jnp.float32)
    d = d.astype(x.dtype).reshape(B, S, N_POOL_GROUPS, G_C)
    z = jnp.einsum('bsgc,gce->bsge', d, w_grp).reshape(B, S, D_C) * scale
    return z @ w_out, ue[:, ue.shape[1] - POOL_HIST:]


def _swiglu(x, w1, w3, w2):
    return (jax.nn.silu(x @ w1) * (x @ w3)) @ w2


def _trunk(x, pos0, wb, cache_kv, page_table, state_win, state_conv, state_pool, p):
    B = x.shape[0]
    kv_new, win_new, conv_new, pool_new = [], [], [], []
    for l in range(DEPTH):
        if l % 2 == 0:
            ia = l // 2
            if cache_kv is None:
                past_kv, win_past, conv_past = None, None, None
            else:
                past_kv = cache_kv[ia, page_table].reshape(B, -1, 4, KVH, HD)
                win_past, conv_past = state_win[ia], state_conv[ia]
            h, kv_n, win_n, conv_n = _nsa_conv_mixer(
                x, pos0, wb, past_kv, win_past, conv_past,
                p['w_in_a'][ia], p['w_cmp_k'][ia], p['pe_cmp_k'][ia], p['w_cmp_v'][ia], p['pe_cmp_v'][ia],
                p['conv_w'][ia], p['conv_b'][ia], p['conv_ln_g'][ia], p['conv_ln_b'][ia], p['w_out_a'][ia])
            kv_new.append(kv_n)
            win_new.append(win_n)
            conv_new.append(conv_n)
        else:
            ic = l // 2
            pool_past = None if state_pool is None else state_pool[ic]
            h, pool_n = _pool_mixer(x, pos0, pool_past, p['w_in_c'][ic], p['w_grp_c'][ic],
                                    p['scale_c'][ic], p['w_out_c'][ic])
            pool_new.append(pool_n)
        x = _layer_norm(ALPHA * x + h, p['ln1_g'][l], p['ln1_b'][l])
        x = _layer_norm(ALPHA * x + _swiglu(x, p['w1'][l], p['w3'][l], p['w2'][l]), p['ln2_g'][l], p['ln2_b'][l])
    return x, jnp.stack(kv_new), jnp.stack(win_new), jnp.stack(conv_new), jnp.stack(pool_new)


def setup_inputs(seed: int = 0) -> dict:
    key = jax.random.key(seed)
    k = jax.random.split(key, 32)
    n_pages = PAST_LEN // PAGE_SIZE
    n_used = DEC_BATCH * n_pages
    n_pool = n_used + max(1, n_used // 4)
    wb = min(WINDOW, PAST_LEN)

    def nrm(kk, shape, s=1.0):
        return jax.random.normal(kk, shape, jnp.float32) * s

    page_table = jax.random.permutation(k[0], n_pool)[:n_used].reshape(DEC_BATCH, n_pages).astype(jnp.int32)
    return {
        'x_prompt': nrm(k[1], (BATCH, SEQ, D_MODEL)),
        'x_sample': nrm(k[2], (DEC_BATCH, DEC_SEQ, D_MODEL)),
        'cache_kv': nrm(k[3], (N_A, n_pool, PAGE_SIZE, 4, KVH, HD)),
        'state_win': nrm(k[4], (N_A, DEC_BATCH, wb, 2, KVH, HD)),
        'state_conv': nrm(k[5], (N_A, DEC_BATCH, CONV_W - 1, C_B), 0.5),
        'state_pool': nrm(k[6], (N_C, DEC_BATCH, POOL_HIST, D_C)),
        'page_table': page_table,
        'w_in_a': nrm(k[7], (N_A, D_MODEL, IN_A), D_MODEL ** -0.5),
        'w_cmp_k': nrm(k[8], (N_A, L_CMP, HD, HD), (L_CMP * HD) ** -0.5),
        'pe_cmp_k': nrm(k[9], (N_A, L_CMP, HD), 0.1),
        'w_cmp_v': nrm(k[10], (N_A, L_CMP, HD, HD), (L_CMP * HD) ** -0.5),
        'pe_cmp_v': nrm(k[11], (N_A, L_CMP, HD), 0.1),
        'conv_w': nrm(k[12], (N_A, CONV_W, C_B), CONV_W ** -0.5),
        'conv_b': nrm(k[13], (N_A, C_B), 0.01),
        'conv_ln_g': 1.0 + nrm(k[14], (N_A, C_B), 0.02),
        'conv_ln_b': nrm(k[15], (N_A, C_B), 0.01),
        'w_out_a': nrm(k[16], (N_A, OUT_A, D_MODEL), BETA * OUT_A ** -0.5),
        'w_in_c': nrm(k[17], (N_C, D_MODEL, D_C), D_MODEL ** -0.5),
        'w_grp_c': nrm(k[18], (N_C, N_POOL_GROUPS, G_C, G_C), G_C ** -0.5),
        'scale_c': 1.0 + nrm(k[19], (N_C, D_C), 0.02),
        'w_out_c': nrm(k[20], (N_C, D_C, D_MODEL), BETA * D_C ** -0.5),
        'ln1_g': 1.0 + nrm(k[21], (DEPTH, D_MODEL), 0.02),
        'ln1_b': nrm(k[22], (DEPTH, D_MODEL), 0.01),
        'ln2_g': 1.0 + nrm(k[23], (DEPTH, D_MODEL), 0.02),
        'ln2_b': nrm(k[24], (DEPTH, D_MODEL), 0.01),
        'w1': nrm(k[25], (DEPTH, D_MODEL, D_FF), D_MODEL ** -0.5),
        'w3': nrm(k[26], (DEPTH, D_MODEL, D_FF), D_MODEL ** -0.5),
        'w2': nrm(k[27], (DEPTH, D_FF, D_MODEL), BETA * D_FF ** -0.5),
    }


def reference(x_prompt, x_sample, cache_kv, state_win, state_conv, state_pool, page_table,
              w_in_a, w_cmp_k, pe_cmp_k, w_cmp_v, pe_cmp_v, conv_w, conv_b, conv_ln_g, conv_ln_b,
              w_out_a, w_in_c, w_grp_c, scale_c, w_out_c, ln1_g, ln1_b, ln2_g, ln2_b, w1, w3, w2):
    p = dict(w_in_a=w_in_a, w_cmp_k=w_cmp_k, pe_cmp_k=pe_cmp_k, w_cmp_v=w_cmp_v, pe_cmp_v=pe_cmp_v,
             conv_w=conv_w, conv_b=conv_b, conv_ln_g=conv_ln_g, conv_ln_b=conv_ln_b, w_out_a=w_out_a,
             w_in_c=w_in_c, w_grp_c=w_grp_c, scale_c=scale_c, w_out_c=w_out_c,
             ln1_g=ln1_g, ln1_b=ln1_b, ln2_g=ln2_g, ln2_b=ln2_b, w1=w1, w3=w3, w2=w2)
    wb = state_win.shape[2]
    past_len = page_table.shape[1] * cache_kv.shape[2]
    y_prompt, kv_prompt, win_prompt, conv_prompt, pool_prompt = _trunk(
        x_prompt, 0, wb, None, None, None, None, None, p)
    y_sample, kv_sample, win_sample, conv_sample, pool_sample = _trunk(
        x_sample, past_len, wb, cache_kv, page_table, state_win, state_conv, state_pool, p)
    return (y_prompt, y_sample, kv_prompt, kv_sample, win_prompt, win_sample,
            conv_prompt, conv_sample, pool_prompt, pool_sample)
```

```cpp
#include <hip/hip_runtime.h>
#include <cstdio>
#include <cstdint>

#ifndef PHMASK
#define PHMASK 0xFFFFF
#endif
#define PHON(k) constexpr (((PHMASK) >> (k)) & 1)
#ifndef MK_ONE_LAUNCH
#define MK_ONE_LAUNCH 0
#endif

#define GAS __attribute__((address_space(1)))
#define LAS __attribute__((address_space(3)))
typedef unsigned short bf16;
typedef float f32x4 __attribute__((ext_vector_type(4)));
typedef float f32x16 __attribute__((ext_vector_type(16)));
typedef short bf16x8 __attribute__((ext_vector_type(8)));
typedef unsigned u32x4 __attribute__((ext_vector_type(4)));
typedef unsigned u32x2 __attribute__((ext_vector_type(2)));
typedef float f32x2_t __attribute__((ext_vector_type(2)));
typedef __bf16 bf16x2_t __attribute__((ext_vector_type(2)));

constexpr int DM = 1024, NB_P = 8, SEQ = 2048, NB_S = 128, DSEQ = 8, PAST = 2048, PAGE = 128, NPAGES = 16, NPOOLPG = 2560;
constexpr int MP = NB_P * SEQ, MS = NB_S * DSEQ, M = MP + MS;
constexpr int NSEQ = NB_P + NB_S;
constexpr int HD = 64, NH = 8, KVH = 2;
constexpr int IN_A = 2328, IN_A_PAD = 2560, CB = 512, CONVW = 31, DFF = 2816, WB = 512, PHIST = 15;
constexpr int KLEN = 2112;
constexpr int WLEN_S = 576;
constexpr float LN_EPS = 1e-5f;
constexpr float ALPHA = 1.681792830507429f;
constexpr float C2 = 0.125f * 1.4426950408889634f;
constexpr float NEG_BIG = -1.0e30f;

enum { I_XP = 0, I_XS, I_CACHE, I_SWIN, I_SCONV, I_SPOOL, I_PT, I_WINA, I_WCK, I_PECK, I_WCV, I_PECV, I_CONVW, I_CONVB, I_CLNG, I_CLNB,
       I_WOUTA, I_WINC, I_WGRP, I_SCALEC, I_WOUTC, I_LN1G, I_LN1B, I_LN2G, I_LN2B, I_W1, I_W3, I_W2, N_IN };
constexpr size_t O_Y = 0;
constexpr size_t O_KVP = (size_t)M * DM;
constexpr size_t O_KVS = O_KVP + (size_t)2 * MP * 512;
constexpr size_t O_WINP = O_KVS + (size_t)2 * MS * 512;
constexpr size_t O_WINS = O_WINP + (size_t)2 * NB_P * WB * 256;
constexpr size_t O_CONVP = O_WINS + (size_t)2 * NB_S * WB * 256;
constexpr size_t O_CONVS = O_CONVP + (size_t)2 * NB_P * 30 * CB;
constexpr size_t O_POOLP = O_CONVS + (size_t)2 * NB_S * 30 * CB;
constexpr size_t O_POOLS = O_POOLP + (size_t)2 * NB_P * PHIST * DM;
constexpr size_t O_END = O_POOLS + (size_t)2 * NB_S * PHIST * DM;
static_assert(O_END == 79659008, "output size");

constexpr size_t al256(size_t x) { return (x + 255) & ~(size_t)255; }
constexpr size_t WS_CTL = 0, CTL_ZERO_BYTES = 1u << 20;
constexpr size_t WS_WA = CTL_ZERO_BYTES;
constexpr size_t WS_WO = WS_WA + (size_t)2 * IN_A_PAD * DM * 2;
constexpr size_t WS_WCIN = WS_WO + (size_t)2 * DM * DM * 2;
constexpr size_t WS_WCOUT = WS_WCIN + (size_t)2 * DM * DM * 2;
constexpr size_t WS_WG = WS_WCOUT + (size_t)2 * DM * DM * 2;
constexpr size_t WS_W13 = WS_WG + (size_t)2 * DM * DM * 2;
constexpr size_t WS_W2 = WS_W13 + (size_t)4 * 2 * DFF * DM * 2;
constexpr size_t WS_WCMP = WS_W2 + (size_t)4 * DM * DFF * 2;
constexpr size_t WS_BIASC = WS_WCMP + (size_t)4 * 64 * 2048 * 2;
constexpr size_t WS_ROPE = al256(WS_BIASC + 4 * 64 * 4);
constexpr size_t WS_XF = al256(WS_ROPE + (size_t)KLEN * 32 * 2 * 4);
constexpr size_t WS_XB = WS_XF + (size_t)M * DM * 4;
constexpr size_t WS_H = WS_XB + (size_t)M * DM * 2;
constexpr size_t WS_Q = WS_H + (size_t)M * IN_A_PAD * 4;
constexpr size_t WS_KSEL = WS_Q + (size_t)M * 512 * 2;
constexpr size_t KSEL_L = (size_t)NSEQ * KLEN * 128;
constexpr size_t WS_VSELT = WS_KSEL + 2 * KSEL_L * 2;
constexpr size_t WS_KWIN = WS_VSELT + 2 * KSEL_L * 2;
constexpr size_t WROWS = (size_t)MP + (size_t)NB_S * WLEN_S;
constexpr size_t KWIN_L = WROWS * 128;
constexpr size_t WS_VWINT = WS_KWIN + 2 * KWIN_L * 2;
constexpr size_t WS_KCMP = WS_VWINT + 2 * KWIN_L * 2;
constexpr size_t KCMP_L = (size_t)NSEQ * 64 * 128;
constexpr size_t WS_VCMPT = WS_KCMP + 2 * KCMP_L * 2;
constexpr size_t WS_GATES = WS_VCMPT + 2 * KCMP_L * 2;
constexpr size_t WS_U = al256(WS_GATES + (size_t)M * 24 * 4);
constexpr size_t WS_ACAT = WS_U + (size_t)M * CB * 4;
constexpr size_t WS_V = WS_ACAT + (size_t)M * DM * 2;
constexpr size_t WS_HF = WS_V + (size_t)M * DM * 4;
constexpr size_t WS_UC = WS_HF + (size_t)M * DFF * 2;
constexpr size_t WS_D = WS_UC + (size_t)M * DM * 4;
constexpr size_t WS_Z = WS_D + (size_t)M * DM * 2;
constexpr size_t WS_END = WS_Z + (size_t)M * DM * 2;
constexpr int CW_ATT = 64;
constexpr int CW_BAR = 4096;

constexpr int RING_BYTES = 131072, LDSCTL_OFF = RING_BYTES, MISC_OFF = LDSCTL_OFF + 320, LDS_BYTES = 147456;
constexpr int NWAVES = 8;

__device__ __forceinline__ unsigned pk2(float lo, float hi) { f32x2_t v = {lo, hi}; bf16x2_t b = __builtin_convertvector(v, bf16x2_t); return __builtin_bit_cast(unsigned, b); }
__device__ __forceinline__ bf16 f2bf(float f) { return (bf16)(pk2(f, 0.f) & 0xffffu); }
__device__ __forceinline__ float wave_sum(float v) {
#pragma unroll
    for (int o = 1; o < 64; o <<= 1) v += __shfl_xor(v, o);
    return v;
}
__device__ __forceinline__ float sigmoidf_(float x) { return __builtin_amdgcn_rcpf(1.f + __expf(-x)); }
__device__ __forceinline__ int vt_col(int t) { const int x = t & 15; return (t & ~15) | (x & 3) | ((x & 4) << 1) | ((x & 8) >> 1); }
#define LDS_WAIT() asm volatile("s_waitcnt lgkmcnt(0)" ::: "memory")
#define VM_WAIT() asm volatile("s_waitcnt vmcnt(0)" ::: "memory")

namespace pg8 {
#define PG8_LAS __attribute__((address_space(3)))
typedef unsigned short bf16_t;
constexpr int BM = 256, BK = 64, HALF = 128, HTB = HALF * BK * 2, STAGE_BYTES = 8 * HTB, NXCD = 8, WGM = 8;
__host__ __device__ __forceinline__ int lds_byte(int r, int c) { const int st = (r >> 4) * 2 + (c >> 5), rr = r & 15, cc = c & 31, ob = rr * 64 + cc * 2; return st * 1024 + (ob ^ (((ob >> 9) & 1) << 5)); }
__host__ __device__ __forceinline__ void stage_rc(int b, int& R, int& C) { const int st = b / 1024, sb = b % 1024, swz = sb ^ (((sb >> 9) & 1) << 5); R = (st >> 1) * 16 + swz / 64; C = (st & 1) * 32 + (swz % 64) / 2; }
__host__ __device__ __forceinline__ int perm32(int rho) { const int n = rho >> 4, i = rho & 15; return 8 * (i >> 2) + 4 * n + (i & 3); }
struct Unit { int pm, pn; };
struct Gemm { const bf16_t* A; const bf16_t* Bt; int M, N, K, lda, ldb; size_t pn_koff; };
struct StaticOrder {
    int nM, nN, nwg, G, c;
    __host__ __device__ void init(int M, int N, int G_, int c_) { nM = M / BM; nN = N / BM; nwg = nM * nN; G = G_; c = c_; }
    __host__ __device__ bool next(int i, Unit& u) const {
        const long L = (long)i * G + c; if (L >= nwg) return false;
        int wgid = (int)L; { const int q = nwg / NXCD, r = nwg % NXCD, xcd = wgid % NXCD, off = wgid / NXCD; wgid = (xcd < r ? xcd * (q + 1) : r * (q + 1) + (xcd - r) * q) + off; }
        const int nig = WGM * nN, gid = wgid / nig, fm = gid * WGM, gsz = (nM - fm) < WGM ? (nM - fm) : WGM;
        u.pm = fm + ((wgid % nig) % gsz); u.pn = (wgid % nig) / gsz; return true;
    }
    __device__ __forceinline__ void a_ready(const Unit&) const {}
    __device__ __forceinline__ void done(const Unit&) const {}
};
struct EpiF32 {
    static constexpr bool PERM = false;
    float* O; int ldc;
    __device__ __forceinline__ void operator()(const f32x4 (&acc)[2][2][4][2], const Unit& u, int wr, int wc, int fr, int fq) const {
        const int row0 = u.pm * BM + wr * 64 + fr, col0 = u.pn * BM + wc * 32 + 4 * fq;
#pragma unroll
        for (int ai = 0; ai < 2; ++ai)
#pragma unroll
            for (int m = 0; m < 4; ++m) { float* rowp = O + (size_t)(row0 + ai * HALF + m * 16) * ldc + col0;
#pragma unroll
                for (int bj = 0; bj < 2; ++bj)
#pragma unroll
                    for (int n = 0; n < 2; ++n) *(f32x4*)(rowp + bj * HALF + n * 16) = acc[ai][bj][m][n]; }
    }
};
struct EpiRes {
    static constexpr bool PERM = false;
    const float* X; float* V; float alpha;
    __device__ __forceinline__ void operator()(const f32x4 (&acc)[2][2][4][2], const Unit& u, int wr, int wc, int fr, int fq) const {
        const int row0 = u.pm * BM + wr * 64 + fr, col0 = u.pn * BM + wc * 32 + 4 * fq;
#pragma unroll
        for (int ai = 0; ai < 2; ++ai)
#pragma unroll
            for (int m = 0; m < 4; ++m) { const size_t off = (size_t)(row0 + ai * HALF + m * 16) * 1024 + col0;
#pragma unroll
                for (int bj = 0; bj < 2; ++bj)
#pragma unroll
                    for (int n = 0; n < 2; ++n) { const f32x4 x = *(const f32x4*)(X + off + bj * HALF + n * 16); *(f32x4*)(V + off + bj * HALF + n * 16) = x * alpha + acc[ai][bj][m][n]; } }
    }
};
struct EpiScaleBf16 {
    static constexpr bool PERM = true;
    bf16_t* O; int ldc; const float* scale;
    __device__ __forceinline__ void operator()(const f32x4 (&acc)[2][2][4][2], const Unit& u, int wr, int wc, int fr, int fq) const {
        const int row0 = u.pm * BM + wr * 64 + fr, col0 = u.pn * BM + wc * 32 + 8 * fq;
#pragma unroll
        for (int bj = 0; bj < 2; ++bj) {
            const f32x4 sv0 = *(const f32x4*)(scale + col0 + bj * HALF), sv1 = *(const f32x4*)(scale + col0 + bj * HALF + 4);
#pragma unroll
            for (int ai = 0; ai < 2; ++ai)
#pragma unroll
                for (int m = 0; m < 4; ++m) { bf16_t* rowp = O + (size_t)(row0 + ai * HALF + m * 16) * ldc + col0;
                    const f32x4 v0 = acc[ai][bj][m][0] * sv0, v1 = acc[ai][bj][m][1] * sv1;
                    u32x4 w; w.x = pk2(v0[0], v0[1]); w.y = pk2(v0[2], v0[3]); w.z = pk2(v1[0], v1[1]); w.w = pk2(v1[2], v1[3]);
                    *(u32x4*)(rowp + bj * HALF) = w; asm volatile("" ::: "memory"); }
        }
    }
};
struct EpiSwiglu {
    static constexpr bool PERM = true;
    bf16_t* O; int ldc;
    __device__ __forceinline__ void operator()(const f32x4 (&acc)[2][2][4][2], const Unit& u, int wr, int wc, int fr, int fq) const {
        const int row0 = u.pm * BM + wr * 64 + fr, col0 = u.pn * HALF + wc * 32 + 8 * fq;
#pragma unroll
        for (int ai = 0; ai < 2; ++ai)
#pragma unroll
            for (int m = 0; m < 4; ++m) { bf16_t* rowp = O + (size_t)(row0 + ai * HALF + m * 16) * ldc + col0;
                float h[8];
#pragma unroll
                for (int n = 0; n < 2; ++n)
#pragma unroll
                    for (int j = 0; j < 4; ++j) { const float a = acc[ai][0][m][n][j], b = acc[ai][1][m][n][j]; h[4 * n + j] = a * __builtin_amdgcn_rcpf(1.f + __expf(-a)) * b; }
                u32x4 w; w.x = pk2(h[0], h[1]); w.y = pk2(h[2], h[3]); w.z = pk2(h[4], h[5]); w.w = pk2(h[6], h[7]);
                *(u32x4*)rowp = w; }
    }
};

template <class Epi, class Sched, bool ALIGN_EPI = false, bool SP2 = false>
__device__ __forceinline__ void gemm_phase(PG8_LAS unsigned char* lds, const Gemm g, const Sched& S, const Epi& E) {
    int tid_ = threadIdx.x; asm volatile("" : "+v"(tid_));
    const int tid = tid_, wid = __builtin_amdgcn_readfirstlane(tid >> 6), lane = tid & 63, wr = wid >> 2, wc = wid & 3, fr = lane & 15, fq = lane >> 4;
    int K_ = g.K; asm volatile("" : "+s"(K_));
    const int K = K_, nt = K / BK;
    unsigned voffA[2], voffB[2];
#pragma unroll
    for (int i = 0; i < 2; ++i) { int R, C; stage_rc(tid * 16 + i * 8192, R, C); const int Rb = Epi::PERM ? ((R & ~31) + perm32(R & 31)) : R;
        voffA[i] = (unsigned)(R * g.lda + C) * 2u; voffB[i] = (unsigned)(Rb * g.ldb + C) * 2u; }
    const size_t kstep = (size_t)(BK * 2);
    const size_t hstepA = (size_t)HALF * g.lda * 2, hstepB = (size_t)HALF * g.ldb * 2;
    const size_t tstepA = 2 * hstepA, tstepB = 2 * hstepB;
    const unsigned ldsw = (unsigned)wid * 1024u;
    const int aoff = lds_byte(wr * 64 + fr, fq * 8), boff = lds_byte(wc * 32 + fr, fq * 8);
#define PG8_SA(b, h) (((b) * 2 + (h)) * HTB)
#define PG8_SB(b, h) ((4 + (b) * 2 + (h)) * HTB)
#define PG8_STAGE(bufoff, gbase, voff) do { _Pragma("unroll") for (int _i = 0; _i < 2; ++_i) \
        __builtin_amdgcn_global_load_lds((const unsigned*)((const char*)(gbase) + (voff)[_i]), (PG8_LAS unsigned*)(lds + (bufoff) + ldsw + _i * 8192), 16, 0, 0); } while (0)
#define PG8_LDA(dst, b, h) do { _Pragma("unroll") for (int m = 0; m < 4; ++m) _Pragma("unroll") for (int k = 0; k < 2; ++k) dst[m][k] = *(const PG8_LAS bf16x8*)(lds + PG8_SA(b, h) + aoff + m * 2048 + k * 1024); } while (0)
#define PG8_LDB(dst, b, h) do { _Pragma("unroll") for (int n = 0; n < 2; ++n) _Pragma("unroll") for (int k = 0; k < 2; ++k) dst[n][k] = *(const PG8_LAS bf16x8*)(lds + PG8_SB(b, h) + boff + n * 2048 + k * 1024); } while (0)
#define PG8_MMA(ai, bj, At, Bt) do { __builtin_amdgcn_s_setprio(1); _Pragma("unroll") for (int m = 0; m < 4; ++m) _Pragma("unroll") for (int n = 0; n < 2; ++n) _Pragma("unroll") for (int k = 0; k < 2; ++k) \
        acc[ai][bj][m][n] = __builtin_amdgcn_mfma_f32_16x16x32_bf16(Bt[n][k], At[m][k], acc[ai][bj][m][n], 0, 0, 0); __builtin_amdgcn_s_setprio(0); } while (0)
#define PG8_WAIT_V(n) asm volatile("s_waitcnt vmcnt(" #n ")" ::: "memory")
#define PG8_WAIT_L(n) asm volatile("s_waitcnt lgkmcnt(" #n ")" ::: "memory")
#define PG8_BAR __builtin_amdgcn_s_barrier()
#define PG8_SCHED __builtin_amdgcn_sched_barrier(0)
    Unit cur, nxt; int ui = 0;
    if (!S.next(0, cur)) return;
    f32x4 acc[2][2][4][2];
#pragma unroll
    for (int a = 0; a < 2; ++a)
#pragma unroll
        for (int b = 0; b < 2; ++b)
#pragma unroll
            for (int m = 0; m < 4; ++m)
#pragma unroll
                for (int n = 0; n < 2; ++n) acc[a][b][m][n] = (f32x4){0.f, 0.f, 0.f, 0.f};
    bf16x8 At[4][2], B0[2][2], B1[2][2];
    const char* cA = (const char*)g.A + (size_t)cur.pm * tstepA + (size_t)cur.pn * g.pn_koff; const char* cB = (const char*)g.Bt + (size_t)cur.pn * (tstepB + g.pn_koff);
    S.a_ready(cur);
    if constexpr (SP2) {
        PG8_STAGE(PG8_SB(0, 0), cB, voffB); PG8_STAGE(PG8_SB(0, 1), cB + hstepB, voffB); PG8_STAGE(PG8_SA(0, 0), cA, voffA); PG8_STAGE(PG8_SA(0, 1), cA + hstepA, voffA);
        if (wr == 1) PG8_BAR;
        PG8_WAIT_V(2); PG8_BAR;
        PG8_STAGE(PG8_SB(1, 0), cB + kstep, voffB); PG8_STAGE(PG8_SA(1, 0), cA + kstep, voffA); PG8_STAGE(PG8_SB(1, 1), cB + hstepB + kstep, voffB);
        PG8_WAIT_V(6); PG8_BAR;
    } else {
        PG8_STAGE(PG8_SB(0, 0), cB, voffB); PG8_STAGE(PG8_SA(0, 0), cA, voffA); PG8_STAGE(PG8_SB(0, 1), cB + hstepB, voffB); PG8_STAGE(PG8_SA(0, 1), cA + hstepA, voffA);
        if (wr == 1) PG8_BAR;
        PG8_WAIT_V(4); PG8_BAR;
        PG8_STAGE(PG8_SB(1, 0), cB + kstep, voffB); PG8_STAGE(PG8_SA(1, 0), cA + kstep, voffA); PG8_STAGE(PG8_SB(1, 1), cB + hstepB + kstep, voffB);
        PG8_WAIT_V(6); PG8_BAR;
    }
    for (;;) {
        const bool has_next = S.next(ui + 1, nxt);
        const char* nA = has_next ? (const char*)g.A + (size_t)nxt.pm * tstepA + (size_t)nxt.pn * g.pn_koff : cA; const char* nB = has_next ? (const char*)g.Bt + (size_t)nxt.pn * (tstepB + g.pn_koff) : cB;
        for (int t = 0; t < nt; t += 2) {
            const bool last = (t == nt - 2);
            const char* a1 = cA + (size_t)(t + 1) * kstep;
            const char* a2 = last ? nA : cA + (size_t)(t + 2) * kstep; const char* b2 = last ? nB : cB + (size_t)(t + 2) * kstep;
            const char* a3 = a2 + kstep; const char* b3 = b2 + kstep;
            if (last && has_next) S.a_ready(nxt);
            if constexpr (SP2) {
            PG8_LDB(B0, 0, 0); PG8_LDB(B1, 0, 1); PG8_SCHED; PG8_LDA(At, 0, 0); PG8_STAGE(PG8_SA(1, 1), a1 + hstepA, voffA);
            PG8_WAIT_V(8); PG8_WAIT_L(0); PG8_BAR; PG8_MMA(0, 0, At, B0); PG8_MMA(0, 1, At, B1); PG8_BAR; PG8_SCHED;
            PG8_LDA(At, 0, 1); PG8_STAGE(PG8_SB(0, 0), b2, voffB); PG8_STAGE(PG8_SB(0, 1), b2 + hstepB, voffB); PG8_STAGE(PG8_SA(0, 0), a2, voffA);
            PG8_WAIT_V(8); PG8_WAIT_L(0); PG8_BAR; PG8_MMA(1, 0, At, B0); PG8_MMA(1, 1, At, B1); PG8_BAR; PG8_SCHED;
            PG8_LDB(B0, 1, 0); PG8_LDB(B1, 1, 1); PG8_SCHED; PG8_LDA(At, 1, 0); PG8_STAGE(PG8_SA(0, 1), a2 + hstepA, voffA);
            PG8_WAIT_V(8); PG8_WAIT_L(0); PG8_BAR; PG8_MMA(0, 0, At, B0); PG8_MMA(0, 1, At, B1); PG8_BAR; PG8_SCHED;
            PG8_LDA(At, 1, 1); PG8_STAGE(PG8_SB(1, 0), b3, voffB); PG8_STAGE(PG8_SB(1, 1), b3 + hstepB, voffB); PG8_STAGE(PG8_SA(1, 0), a3, voffA);
            PG8_WAIT_V(8); PG8_WAIT_L(0); PG8_BAR; PG8_MMA(1, 0, At, B0); PG8_MMA(1, 1, At, B1); PG8_BAR; PG8_SCHED;
            } else {
            PG8_LDB(B0, 0, 0); PG8_SCHED; PG8_LDA(At, 0, 0); PG8_STAGE(PG8_SA(1, 1), a1 + hstepA, voffA);
            PG8_WAIT_L(8); PG8_BAR; PG8_WAIT_L(0); PG8_MMA(0, 0, At, B0); PG8_BAR; PG8_SCHED;
            PG8_LDB(B1, 0, 1); PG8_STAGE(PG8_SB(0, 0), b2, voffB);
            PG8_BAR; PG8_WAIT_L(0); PG8_MMA(0, 1, At, B1); PG8_BAR;
            PG8_LDA(At, 0, 1); PG8_STAGE(PG8_SA(0, 0), a2, voffA);
            PG8_BAR; PG8_WAIT_L(0); PG8_MMA(1, 0, At, B0); PG8_BAR; PG8_SCHED;
            PG8_STAGE(PG8_SB(0, 1), b2 + hstepB, voffB);
            PG8_WAIT_V(6); PG8_BAR; PG8_MMA(1, 1, At, B1); PG8_BAR;
            PG8_LDB(B0, 1, 0); PG8_SCHED; PG8_LDA(At, 1, 0); PG8_STAGE(PG8_SA(0, 1), a2 + hstepA, voffA);
            PG8_WAIT_L(8); PG8_BAR; PG8_WAIT_L(0); PG8_MMA(0, 0, At, B0); PG8_BAR; PG8_SCHED;
            PG8_LDB(B1, 1, 1); PG8_STAGE(PG8_SB(1, 0), b3, voffB);
            PG8_BAR; PG8_WAIT_L(0); PG8_MMA(0, 1, At, B1); PG8_BAR;
            PG8_LDA(At, 1, 1); PG8_STAGE(PG8_SA(1, 0), a3, voffA);
            PG8_BAR; PG8_WAIT_L(0); PG8_MMA(1, 0, At, B0); PG8_BAR; PG8_SCHED;
            PG8_STAGE(PG8_SB(1, 1), b3 + hstepB, voffB);
            PG8_WAIT_V(6); PG8_BAR; PG8_MMA(1, 1, At, B1); PG8_BAR;
            }
        }
        if constexpr (ALIGN_EPI) { if (wr == 0) PG8_BAR; }
        E(acc, cur, wr, wc, fr, fq); S.done(cur);
        if (!has_next) break;
#pragma unroll
        for (int a = 0; a < 2; ++a)
#pragma unroll
            for (int b = 0; b < 2; ++b)
#pragma unroll
                for (int m = 0; m < 4; ++m)
#pragma unroll
                    for (int n = 0; n < 2; ++n) acc[a][b][m][n] = (f32x4){0.f, 0.f, 0.f, 0.f};
        cur = nxt; cA = nA; cB = nB; ++ui;
        if constexpr (ALIGN_EPI) { if (wr == 1) PG8_BAR; }
    }
    PG8_WAIT_V(0);
    if constexpr (!ALIGN_EPI) { if (wr == 0) PG8_BAR; }
    PG8_BAR;
#undef PG8_SA
#undef PG8_SB
#undef PG8_STAGE
#undef PG8_LDA
#undef PG8_LDB
#undef PG8_MMA
#undef PG8_WAIT_V
#undef PG8_WAIT_L
#undef PG8_BAR
#undef PG8_SCHED
}
}

#define XB_TMO      128
#define XB_XCNT(j)  (256  + 64 * (j))
#define XB_XSUB(j)  (1280 + 64 * (j))
#define XB_XGEN(j)  (2304 + 64 * (j))
#define XB_TOP      3328
#define XB_TOPGEN   3392
#define XCD_BAR_WORDS 3456
#define XB_SPIN_CAP (1u << 18)
__device__ __forceinline__ unsigned xb_ld(unsigned* p)              { return __hip_atomic_load(p, __ATOMIC_RELAXED, __HIP_MEMORY_SCOPE_AGENT); }
__device__ __forceinline__ unsigned xb_add(unsigned* p, unsigned v) { return __hip_atomic_fetch_add(p, v, __ATOMIC_RELAXED, __HIP_MEMORY_SCOPE_AGENT); }
__device__ __forceinline__ unsigned xb_xcc_id() { return (unsigned)__builtin_amdgcn_s_getreg((3 << 11) | 20) & 0xFu; }
#define XB_SPIN(cond, bar) do { unsigned _sp = 0; while (cond) { __builtin_amdgcn_s_sleep(1); \
    if ((++_sp & 255u) == 0u) { if (xb_ld(&(bar)[XB_TMO])) break; if (_sp > XB_SPIN_CAP) { atomicAdd(&(bar)[XB_TMO], 1u); break; } } } } while (0)
struct XcdBarrier { unsigned* bar; unsigned x; volatile LAS unsigned* st; };
__device__ __forceinline__ XcdBarrier xcd_barrier_post(unsigned* bar, volatile LAS unsigned* st) {
    XcdBarrier b; b.bar = bar; b.x = xb_xcc_id(); b.st = st;
    if (threadIdx.x == 0) (void)xb_add(&bar[XB_XCNT(b.x)], 1u);
    return b;
}
__device__ __forceinline__ void xcd_barrier_complete(unsigned* bar, unsigned x, unsigned& nloc, unsigned& nx) {
    const unsigned G = gridDim.x * gridDim.y * gridDim.z;
    unsigned sum, cnt, mine, sp = 0u;
    for (;;) {
        sum = 0u; cnt = 0u; mine = 0u;
#pragma unroll
        for (unsigned j = 0; j < 16; ++j) { const unsigned c = xb_ld(&bar[XB_XCNT(j)]); sum += c; cnt += (c > 0u) ? 1u : 0u; mine = (j == x) ? c : mine; }
        if (sum == G) break;
        __builtin_amdgcn_s_sleep(1);
        if ((++sp & 255u) == 0u) { if (xb_ld(&bar[XB_TMO])) break; if (sp > XB_SPIN_CAP) { atomicAdd(&bar[XB_TMO], 1u); break; } }
    }
    nloc = mine > 0u ? mine : 1u; nx = cnt > 0u ? cnt : 1u;
}
__device__ __forceinline__ void xcd_barrier(const XcdBarrier& b) {
    asm volatile("s_waitcnt vmcnt(0)" ::: "memory");
    __syncthreads();
    if (threadIdx.x == 0) {
        unsigned* bar = b.bar;
        __builtin_amdgcn_s_waitcnt(0);
        unsigned nloc = b.st[0], nx = b.st[1];
        if (nloc == 0u) { xcd_barrier_complete(bar, b.x, nloc, nx); b.st[0] = nloc; b.st[1] = nx; }
        const unsigned old = xb_add(&bar[XB_XSUB(b.x)], 1u);
        const unsigned gen = old / nloc;
        if (old + 1u == (gen + 1u) * nloc) {
            __builtin_amdgcn_fence(__ATOMIC_RELEASE, "agent");
            asm volatile("s_waitcnt vmcnt(0)" ::: "memory");
            const unsigned og = xb_add(&bar[XB_TOP], 1u);
            const unsigned tg = og / nx;
            if (og + 1u == (tg + 1u) * nx) xb_add(&bar[XB_TOPGEN], 1u);
            else XB_SPIN(xb_ld(&bar[XB_TOPGEN]) == tg, bar);
            __builtin_amdgcn_fence(__ATOMIC_ACQUIRE, "agent");
            xb_add(&bar[XB_XGEN(b.x)], 1u);
            asm volatile("s_waitcnt vmcnt(0)" ::: "memory");
        } else {
            XB_SPIN(xb_ld(&bar[XB_XGEN(b.x)]) == gen, bar);
            __builtin_amdgcn_fence(__ATOMIC_ACQUIRE, "agent");
            asm volatile("s_waitcnt vmcnt(0)" ::: "memory");
        }
    }
    __syncthreads();
}

struct Args { const float* in[N_IN]; float* out; unsigned char* ws; int ph_lo, ph_hi; };
struct Frame {
    LAS unsigned char* lds;
    unsigned* ctl;
    int tid, lane, wave, G, gw, NGW;
    const float* const* in; float* out; unsigned char* ws;
};
__device__ __forceinline__ void row_info(int m, int& bq, int& t, int& pos) {
    if (m < MP) { bq = m >> 11; t = m & 2047; pos = t; } else { const int s = m - MP; bq = NB_P + (s >> 3); t = s & 7; pos = PAST + t; }
}
__device__ __forceinline__ int seq_row0(int bq) { return bq < NB_P ? bq * SEQ : MP + (bq - NB_P) * DSEQ; }
__device__ __forceinline__ size_t kwin_row0(int bq) { return bq < NB_P ? (size_t)bq * SEQ : (size_t)MP + (size_t)(bq - NB_P) * WLEN_S; }
__device__ __forceinline__ size_t vwint_base(int bq, int g, int& len) {
    if (bq < NB_P) { len = SEQ; return ((size_t)bq * 2 + g) * 64 * SEQ; }
    len = WLEN_S; return (size_t)NB_P * 2 * 64 * SEQ + ((size_t)(bq - NB_P) * 2 + g) * 64 * WLEN_S;
}

__device__ __forceinline__ void transpose_item(const float* W, int K, int N, int Npad, bf16* WT, int ldt, int grp, int gstride, int off, LAS float* scr, int item, int lane) {
    const int nblk = Npad / 32, kb = item / nblk, nb = item % nblk, k0 = 64 * kb, n0 = 32 * nb;
    const int nn = n0 + (lane & 31);
#pragma unroll 8
    for (int i = 0; i < 32; ++i) { const int kk = 2 * i + (lane >> 5); scr[kk * 33 + (lane & 31)] = (nn < N) ? W[(size_t)(k0 + kk) * N + nn] : 0.f; }
    LDS_WAIT(); asm volatile("" ::: "memory");
    const int c = lane & 7;
    const int drow0 = (n0 / grp) * gstride + (n0 % grp) + off;
#pragma unroll
    for (int j = 0; j < 4; ++j) { const int n = (lane >> 3) + 8 * j; const LAS float* s = scr + (8 * c) * 33 + n;
        u32x4 o; o.x = pk2(s[0 * 33], s[1 * 33]); o.y = pk2(s[2 * 33], s[3 * 33]); o.z = pk2(s[4 * 33], s[5 * 33]); o.w = pk2(s[6 * 33], s[7 * 33]);
        *(u32x4*)(WT + (size_t)(drow0 + n) * ldt + k0 + 8 * c) = o; }
    LDS_WAIT(); asm volatile("" ::: "memory");
}
constexpr int TI_WA = 16 * 80, TI_SQ = 16 * 32, TI_CMP = 32 * 2, TI_WG = 4 * 8, TI_W13 = 16 * 88, TI_W2 = 44 * 32;
constexpr int TI_TOTAL = 2 * TI_WA + 2 * TI_SQ + 4 * TI_CMP + 4 * TI_SQ + 8 * TI_WG + 8 * TI_W13 + 4 * TI_W2;
__device__ __forceinline__ void p0_weights(Frame& F) {
    LAS float* scr = (LAS float*)(F.lds + F.wave * 16384);
    unsigned char* ws = F.ws;
    for (int it = F.gw; it < TI_TOTAL; it += F.NGW) {
        int r = it;
        if (r < 2 * TI_WA) { const int ia = r / TI_WA; transpose_item(F.in[I_WINA] + (size_t)ia * DM * IN_A, DM, IN_A, IN_A_PAD, (bf16*)(ws + WS_WA) + (size_t)ia * IN_A_PAD * DM, DM, 1 << 20, 0, 0, scr, r % TI_WA, F.lane); continue; } r -= 2 * TI_WA;
        if (r < 2 * TI_SQ) { const int ia = r / TI_SQ; transpose_item(F.in[I_WOUTA] + (size_t)ia * DM * DM, DM, DM, DM, (bf16*)(ws + WS_WO) + (size_t)ia * DM * DM, DM, 1 << 20, 0, 0, scr, r % TI_SQ, F.lane); continue; } r -= 2 * TI_SQ;
        if (r < 4 * TI_CMP) { const int q = r / TI_CMP, ia = q >> 1, kv = q & 1; transpose_item(F.in[kv ? I_WCV : I_WCK] + (size_t)ia * 2048 * 64, 2048, 64, 64, (bf16*)(ws + WS_WCMP) + (size_t)q * 64 * 2048, 2048, 1 << 20, 0, 0, scr, r % TI_CMP, F.lane); continue; } r -= 4 * TI_CMP;
        if (r < 2 * TI_SQ) { const int ic = r / TI_SQ; transpose_item(F.in[I_WINC] + (size_t)ic * DM * DM, DM, DM, DM, (bf16*)(ws + WS_WCIN) + (size_t)ic * DM * DM, DM, 1 << 20, 0, 0, scr, r % TI_SQ, F.lane); continue; } r -= 2 * TI_SQ;
        if (r < 2 * TI_SQ) { const int ic = r / TI_SQ; transpose_item(F.in[I_WOUTC] + (size_t)ic * DM * DM, DM, DM, DM, (bf16*)(ws + WS_WCOUT) + (size_t)ic * DM * DM, DM, 1 << 20, 0, 0, scr, r % TI_SQ, F.lane); continue; } r -= 2 * TI_SQ;
        if (r < 8 * TI_WG) { const int q = r / TI_WG; transpose_item(F.in[I_WGRP] + (size_t)q * 256 * 256, 256, 256, 256, (bf16*)(ws + WS_WG) + (size_t)(q >> 2) * DM * DM + (size_t)(q & 3) * 256 * (DM + 1), DM, 1 << 20, 0, 0, scr, r % TI_WG, F.lane); continue; } r -= 8 * TI_WG;
        if (r < 8 * TI_W13) { const int q = r / TI_W13, l = q >> 1, w3 = q & 1; transpose_item(F.in[w3 ? I_W3 : I_W1] + (size_t)l * DM * DFF, DM, DFF, DFF, (bf16*)(ws + WS_W13) + (size_t)l * 2 * DFF * DM, DM, 128, 256, w3 * 128, scr, r % TI_W13, F.lane); continue; } r -= 8 * TI_W13;
        { const int l = r / TI_W2; transpose_item(F.in[I_W2] + (size_t)l * DFF * DM, DFF, DM, DM, (bf16*)(ws + WS_W2) + (size_t)l * DM * DFF, DFF, 1 << 20, 0, 0, scr, r % TI_W2, F.lane); }
    }
}
__device__ __forceinline__ void p0_misc(Frame& F) {
    unsigned char* ws = F.ws;
    float* XF = (float*)(ws + WS_XF); bf16* XB = (bf16*)(ws + WS_XB);
    for (int m = F.gw; m < M; m += F.NGW) {
        const float* src = (m < MP) ? F.in[I_XP] + (size_t)m * DM : F.in[I_XS] + (size_t)(m - MP) * DM;
#pragma unroll
        for (int j = 0; j < 4; ++j) { const f32x4 v = *((const f32x4*)src + F.lane + 64 * j); *((f32x4*)(XF + (size_t)m * DM) + F.lane + 64 * j) = v;
            u32x2 w; w.x = pk2(v[0], v[1]); w.y = pk2(v[2], v[3]); *((u32x2*)(XB + (size_t)m * DM) + F.lane + 64 * j) = w; }
    }
    float* rope = (float*)(ws + WS_ROPE);
    for (int e = F.gw * 64 + F.lane; e < KLEN * 32; e += F.NGW * 64) {
        const int pos = e >> 5, i = e & 31;
        const float inv = powf(10000.0f, -(float)i / 32.0f);
        const float ang = (float)pos * inv;
        rope[2 * e] = cosf(ang); rope[2 * e + 1] = sinf(ang);
    }
    float* biasc = (float*)(ws + WS_BIASC);
    for (int o = F.gw; o < 4 * 64; o += F.NGW) {
        const int q = o >> 6, e = o & 63, ia = q >> 1, kv = q & 1;
        const float* pe = F.in[kv ? I_PECV : I_PECK] + (size_t)ia * 2048; const float* w = F.in[kv ? I_WCV : I_WCK] + (size_t)ia * 2048 * 64;
        float s = 0.f;
        for (int k = F.lane; k < 2048; k += 64) s += pe[k] * w[(size_t)k * 64 + e];
        s = wave_sum(s);
        if (F.lane == 0) biasc[o] = s;
    }
}
__device__ __forceinline__ void convert_kv_tile(const float* src, int rstride, int koff, int voff, bf16* kdst, bf16* vdst, int vlen, int slot0, LAS bf16* scr, int lane) {
#pragma unroll 4
    for (int j = 0; j < 64; j += 2) { const int tok = j + (lane >> 5), c = (lane & 31) * 4;
        const f32x4 v = *(const f32x4*)(src + (size_t)tok * rstride + koff + c);
        u32x2 w; w.x = pk2(v[0], v[1]); w.y = pk2(v[2], v[3]); *(u32x2*)(kdst + (size_t)tok * 128 + c) = w; }
    const int col = vt_col(slot0 + lane);
    for (int gh = 0; gh < 2; ++gh) {
#pragma unroll 4
        for (int j = 0; j < 64; j += 4) { const int tok = j + (lane >> 4), c = (lane & 15) * 4;
            const f32x4 v = *(const f32x4*)(src + (size_t)tok * rstride + voff + gh * 64 + c);
            LAS unsigned* p = (LAS unsigned*)(scr + tok * 66 + c); p[0] = pk2(v[0], v[1]); p[1] = pk2(v[2], v[3]); }
        LDS_WAIT(); asm volatile("" ::: "memory");
#pragma unroll 4
        for (int c = 0; c < 64; ++c) vdst[(size_t)(gh * 64 + c) * vlen + col] = scr[lane * 66 + c];
        LDS_WAIT(); asm volatile("" ::: "memory");
    }
}
template <class RowPtr>
__device__ __forceinline__ void compress_task(const RowPtr& rowptr, const bf16* WT  , const float* bias  , const float* rope, int kv, int half, bf16* kcmp_row0  , bf16* vcmpt_gd0  , int lane) {
    const int r = lane & 31, h = lane >> 5, n = 32 * half + r;
    f32x16 acc0 = {}, acc1 = {};
    for (int p = 0; p < 32; ++p) {
        const float* src = rowptr(n, p);
        const bf16* w0 = WT + (size_t)r * 2048 + p * 64 + 8 * h;
        const bf16* w1 = w0 + (size_t)32 * 2048;
#pragma unroll
        for (int s = 0; s < 4; ++s) {
            const f32x4 a0 = *(const f32x4*)(src + 16 * s + 8 * h), a1 = *(const f32x4*)(src + 16 * s + 8 * h + 4);
            u32x4 aw; aw.x = pk2(a0[0], a0[1]); aw.y = pk2(a0[2], a0[3]); aw.z = pk2(a1[0], a1[1]); aw.w = pk2(a1[2], a1[3]);
            const bf16x8 af = __builtin_bit_cast(bf16x8, aw);
            const bf16x8 b0 = *(const bf16x8*)(w0 + 16 * s), b1 = *(const bf16x8*)(w1 + 16 * s);
            acc0 = __builtin_amdgcn_mfma_f32_32x32x16_bf16(af, b0, acc0, 0, 0, 0);
            acc1 = __builtin_amdgcn_mfma_f32_32x32x16_bf16(af, b1, acc1, 0, 0, 0);
        }
    }
    const float bi0 = bias[r], bi1 = bias[r + 32];
#pragma unroll
    for (int reg = 0; reg < 16; ++reg) {
        const int nn = 32 * half + (reg & 3) + 8 * (reg >> 2) + 4 * h;
        float x1 = acc0[reg] + bi0, x2 = acc1[reg] + bi1;
        if (kv == 0) {
            const int pos = 32 * nn + 31; const float c = rope[(pos * 32 + r) * 2], sn = rope[(pos * 32 + r) * 2 + 1];
            const float o1 = x1 * c - x2 * sn, o2 = x2 * c + x1 * sn;
            kcmp_row0[(size_t)nn * 128 + r] = f2bf(o1); kcmp_row0[(size_t)nn * 128 + r + 32] = f2bf(o2);
        } else {
            vcmpt_gd0[(size_t)r * 64 + vt_col(nn)] = f2bf(x1); vcmpt_gd0[(size_t)(r + 32) * 64 + vt_col(nn)] = f2bf(x2);
        }
    }
}
struct CacheRowPtr { const float* cache_ia; const int* pt_b; int slot_off;
    __device__ __forceinline__ const float* operator()(int n, int p) const { const int page = pt_b[n >> 2]; return cache_ia + ((size_t)page * PAGE + (n & 3) * 32 + p) * 512 + slot_off; } };
struct KvOutRowPtr { const float* base; int slot_off;
    __device__ __forceinline__ const float* operator()(int n, int p) const { return base + (size_t)(32 * n + p) * 512 + slot_off; } };

__device__ __forceinline__ void p0_sample_state(Frame& F) {
    unsigned char* ws = F.ws;
    LAS bf16* scr = (LAS bf16*)(F.lds + F.wave * 8448);
    const int* pt = (const int*)F.in[I_PT];
    for (int it = F.gw; it < 2 * NB_S * 32; it += F.NGW) {
        const int ia = it / (NB_S * 32), rem = it % (NB_S * 32), b = rem >> 5, tt = rem & 31, bq = NB_P + b;
        const int page = pt[b * NPAGES + (tt >> 1)];
        const float* src = F.in[I_CACHE] + (((size_t)ia * NPOOLPG + page) * PAGE + (tt & 1) * 64) * 512;
        bf16* kdst = (bf16*)(ws + WS_KSEL) + ia * KSEL_L + ((size_t)bq * KLEN + 64 * tt) * 128;
        bf16* vdst = (bf16*)(ws + WS_VSELT) + ia * KSEL_L + (size_t)bq * 2 * 64 * KLEN;
        convert_kv_tile(src, 512, 256, 384, kdst, vdst, KLEN, 64 * tt, scr, F.lane);
    }
    for (int it = F.gw; it < 2 * NB_S * 8; it += F.NGW) {
        const int ia = it / (NB_S * 8), rem = it % (NB_S * 8), b = rem >> 3, tt = rem & 7, bq = NB_P + b;
        const float* src = F.in[I_SWIN] + (((size_t)ia * NB_S + b) * WB + 64 * tt) * 256;
        bf16* kdst = (bf16*)(ws + WS_KWIN) + ia * KWIN_L + (kwin_row0(bq) + 64 * tt) * 128;
        int vlen; const size_t vb = vwint_base(bq, 0, vlen);
        bf16* vdst = (bf16*)(ws + WS_VWINT) + ia * KWIN_L + vb;
        convert_kv_tile(src, 256, 0, 128, kdst, vdst, vlen, 64 * tt, scr, F.lane);
        float* wout = F.out + O_WINS + ((size_t)ia * NB_S + b) * WB * 256;
        for (int j = 0; j < 64; ++j) { const int row = 64 * tt + j; if (row >= 8) *((f32x4*)(wout + (size_t)(row - 8) * 256) + F.lane) = *((const f32x4*)(src + (size_t)j * 256) + F.lane); }
    }
    for (int it = F.gw; it < 2 * NB_S * 8; it += F.NGW) {
        const int ia = it / (NB_S * 8), rem = it % (NB_S * 8), b = rem >> 3, kv = (rem >> 2) & 1, g = (rem >> 1) & 1, half = rem & 1, bq = NB_P + b;
        CacheRowPtr rp{F.in[I_CACHE] + (size_t)ia * NPOOLPG * PAGE * 512, pt + b * NPAGES, kv * 128 + g * 64};
        compress_task(rp, (const bf16*)(ws + WS_WCMP) + (size_t)(ia * 2 + kv) * 64 * 2048, (const float*)(ws + WS_BIASC) + (ia * 2 + kv) * 64, (const float*)(ws + WS_ROPE), kv, half,
                      (bf16*)(ws + WS_KCMP) + ia * KCMP_L + (size_t)bq * 64 * 128 + g * 64, (bf16*)(ws + WS_VCMPT) + ia * KCMP_L + ((size_t)bq * 2 + g) * 64 * 64, F.lane);
    }
    for (int it = F.gw; it < 2 * NB_S * 22; it += F.NGW) {
        const int q = it / 22, j = it % 22;
        const float* src = F.in[I_SCONV] + ((size_t)q * 30 + 8 + j) * CB; float* dst = F.out + O_CONVS + ((size_t)q * 30 + j) * CB;
        *((f32x4*)dst + F.lane) = *((const f32x4*)src + F.lane); *((f32x4*)dst + 64 + F.lane) = *((const f32x4*)src + 64 + F.lane);
    }
    for (int it = F.gw; it < 2 * NB_S * 7; it += F.NGW) {
        const int q = it / 7, j = it % 7;
        const float* src = F.in[I_SPOOL] + ((size_t)q * PHIST + 8 + j) * DM; float* dst = F.out + O_POOLS + ((size_t)q * PHIST + j) * DM;
#pragma unroll
        for (int k = 0; k < 4; ++k) *((f32x4*)dst + 64 * k + F.lane) = *((const f32x4*)src + 64 * k + F.lane);
    }
}

__device__ __forceinline__ void a1_post(Frame& F, int ia) {
    unsigned char* ws = F.ws;
    const float* H = (const float*)(ws + WS_H); const float* rope = (const float*)(ws + WS_ROPE);
    bf16* Q = (bf16*)(ws + WS_Q);
    bf16* KSEL = (bf16*)(ws + WS_KSEL) + ia * KSEL_L; bf16* VSELT = (bf16*)(ws + WS_VSELT) + ia * KSEL_L;
    bf16* KWIN = (bf16*)(ws + WS_KWIN) + ia * KWIN_L; bf16* VWINT = (bf16*)(ws + WS_VWINT) + ia * KWIN_L;
    float* GATES = (float*)(ws + WS_GATES); float* U = (float*)(ws + WS_U);
    const int l = F.lane;
    for (int m = F.gw; m < M; m += F.NGW) {
        int bq, t, pos; row_info(m, bq, t, pos);
        const float* h = H + (size_t)m * IN_A_PAD;
        const bool prm = m < MP;
        float* kvo = prm ? F.out + O_KVP + ((size_t)ia * MP + m) * 512 : F.out + O_KVS + ((size_t)ia * MS + (m - MP)) * 512;
        const int i = l & 31; const float cs = rope[(pos * 32 + i) * 2], sn = rope[(pos * 32 + i) * 2 + 1];
#pragma unroll
        for (int k = 0; k < 4; ++k) { const int hh = (l >> 5) + 2 * k; const float x1 = h[hh * 64 + i], x2 = h[hh * 64 + i + 32];
            Q[(size_t)m * 512 + hh * 64 + i] = f2bf((x1 * cs - x2 * sn) * C2); Q[(size_t)m * 512 + hh * 64 + i + 32] = f2bf((x2 * cs + x1 * sn) * C2); }
        kvo[l] = h[512 + l]; kvo[l + 64] = h[512 + 64 + l]; kvo[128 + l] = h[640 + l]; kvo[128 + 64 + l] = h[640 + 64 + l];
        const int g = l >> 5;
        { const float x1 = h[768 + g * 64 + i], x2 = h[768 + g * 64 + i + 32]; const float o1 = x1 * cs - x2 * sn, o2 = x2 * cs + x1 * sn;
          kvo[256 + g * 64 + i] = o1; kvo[256 + g * 64 + i + 32] = o2;
          bf16* kr = KSEL + ((size_t)bq * KLEN + pos) * 128 + g * 64 + i; kr[0] = f2bf(o1); kr[32] = f2bf(o2); }
#pragma unroll
        for (int k = 0; k < 2; ++k) { const int idx = l + 64 * k; const float v = h[896 + idx]; kvo[384 + idx] = v;
            VSELT[((size_t)bq * 2 * 64 + idx) * KLEN + vt_col(pos)] = f2bf(v); }
        const int wi = prm ? pos : pos - 1536;
        float* wo = nullptr;
        if (prm) { if (t >= SEQ - WB) wo = F.out + O_WINP + (((size_t)ia * NB_P + bq) * WB + (t - (SEQ - WB))) * 256; }
        else wo = F.out + O_WINS + (((size_t)ia * NB_S + (bq - NB_P)) * WB + (WB - DSEQ) + t) * 256;
        { const float x1 = h[1024 + g * 64 + i], x2 = h[1024 + g * 64 + i + 32]; const float o1 = x1 * cs - x2 * sn, o2 = x2 * cs + x1 * sn;
          bf16* kr = KWIN + (kwin_row0(bq) + wi) * 128 + g * 64 + i; kr[0] = f2bf(o1); kr[32] = f2bf(o2);
          if (wo) { wo[g * 64 + i] = o1; wo[g * 64 + i + 32] = o2; } }
#pragma unroll
        for (int k = 0; k < 2; ++k) { const int idx = l + 64 * k; const float v = h[1152 + idx];
            int vlen; const size_t vb = vwint_base(bq, idx >> 6, vlen);
            VWINT[vb + (size_t)(idx & 63) * vlen + vt_col(wi)] = f2bf(v);
            if (wo) wo[128 + idx] = v; }
        if (l < 24) GATES[(size_t)m * 24 + l] = sigmoidf_(h[1280 + l]);
        float* co = nullptr;
        if (prm) { if (t >= SEQ - 30) co = F.out + O_CONVP + (((size_t)ia * NB_P + bq) * 30 + (t - (SEQ - 30))) * CB; }
        else co = F.out + O_CONVS + (((size_t)ia * NB_S + (bq - NB_P)) * 30 + 22 + t) * CB;
#pragma unroll
        for (int k = 0; k < 8; ++k) { const int ch = l + 64 * k; const float u = h[1304 + ch] * sigmoidf_(h[1816 + ch]); U[(size_t)m * CB + ch] = u; if (co) co[ch] = u; }
    }
}

__device__ __forceinline__ void a2_compress_prompt(Frame& F, int ia) {
    unsigned char* ws = F.ws;
    for (int it = F.gw; it < NB_P * 8; it += F.NGW) {
        const int b = it >> 3, kv = (it >> 2) & 1, g = (it >> 1) & 1, half = it & 1;
        KvOutRowPtr rp{F.out + O_KVP + ((size_t)ia * MP + (size_t)b * SEQ) * 512, kv * 128 + g * 64};
        compress_task(rp, (const bf16*)(ws + WS_WCMP) + (size_t)(ia * 2 + kv) * 64 * 2048, (const float*)(ws + WS_BIASC) + (ia * 2 + kv) * 64, (const float*)(ws + WS_ROPE), kv, half,
                      (bf16*)(ws + WS_KCMP) + ia * KCMP_L + (size_t)b * 64 * 128 + g * 64, (bf16*)(ws + WS_VCMPT) + ia * KCMP_L + ((size_t)b * 2 + g) * 64 * 64, F.lane);
    }
}
__device__ __forceinline__ void a2_conv(Frame& F, int ia) {
    unsigned char* ws = F.ws;
    const float* U = (const float*)(ws + WS_U); bf16* ACAT = (bf16*)(ws + WS_ACAT);
    const float* cw = F.in[I_CONVW] + (size_t)ia * CONVW * CB; const float* cbias = F.in[I_CONVB] + ia * CB;
    const float* lg = F.in[I_CLNG] + ia * CB; const float* lb = F.in[I_CLNB] + ia * CB;
    const int ch0 = 8 * F.lane;
    for (int it = F.NGW - 1 - F.gw; it < M / 8; it += F.NGW) {
        const int m0 = it * 8; int bq, t0, pos0; row_info(m0, bq, t0, pos0);
        const float* hist = (m0 >= MP) ? F.in[I_SCONV] + ((size_t)ia * NB_S + (bq - NB_P)) * 30 * CB : nullptr;
        auto ldrow = [&](int tau, f32x4& a, f32x4& b) {
            if (tau >= 0) { const float* p = U + (size_t)(m0 - t0 + tau) * CB + ch0; a = *(const f32x4*)p; b = *(const f32x4*)(p + 4); }
            else if (hist) { const float* p = hist + (size_t)(30 + tau) * CB + ch0; a = *(const f32x4*)p; b = *(const f32x4*)(p + 4); }
            else { a = (f32x4){0.f, 0.f, 0.f, 0.f}; b = a; } };
        f32x4 acc[8][2], win[8][2];
        { const f32x4 b0 = *(const f32x4*)(cbias + ch0), b1 = *(const f32x4*)(cbias + ch0 + 4);
#pragma unroll
          for (int tt = 0; tt < 8; ++tt) { acc[tt][0] = b0; acc[tt][1] = b1; } }
#pragma unroll
        for (int tt = 0; tt < 8; ++tt) ldrow(t0 + tt - 30, win[tt][0], win[tt][1]);
        for (int j = 0; j < CONVW; ++j) {
            const f32x4 w0 = *(const f32x4*)(cw + (size_t)j * CB + ch0), w1 = *(const f32x4*)(cw + (size_t)j * CB + ch0 + 4);
#pragma unroll
            for (int tt = 0; tt < 8; ++tt) { acc[tt][0] += w0 * win[tt][0]; acc[tt][1] += w1 * win[tt][1]; }
#pragma unroll
            for (int tt = 0; tt < 7; ++tt) { win[tt][0] = win[tt + 1][0]; win[tt][1] = win[tt + 1][1]; }
            if (j + 1 < CONVW) ldrow(t0 + 7 - 30 + j + 1, win[7][0], win[7][1]);
        }
        const f32x4 g0 = *(const f32x4*)(lg + ch0), g1 = *(const f32x4*)(lg + ch0 + 4), bb0 = *(const f32x4*)(lb + ch0), bb1 = *(const f32x4*)(lb + ch0 + 4);
#pragma unroll
        for (int tt = 0; tt < 8; ++tt) {
            const f32x4 a = acc[tt][0], b = acc[tt][1];
            const float mean = wave_sum((a[0] + a[1]) + (a[2] + a[3]) + (b[0] + b[1]) + (b[2] + b[3])) * (1.f / CB);
            const f32x4 da = a - mean, db = b - mean;
            const float var = wave_sum((da[0] * da[0] + da[1] * da[1]) + (da[2] * da[2] + da[3] * da[3]) + (db[0] * db[0] + db[1] * db[1]) + (db[2] * db[2] + db[3] * db[3])) * (1.f / CB);
            const float rstd = 1.0f / sqrtf(var + LN_EPS);
            f32x4 ya = da * rstd * g0 + bb0, yb = db * rstd * g1 + bb1;
#pragma unroll
            for (int k = 0; k < 4; ++k) { ya[k] = ya[k] * sigmoidf_(ya[k]); yb[k] = yb[k] * sigmoidf_(yb[k]); }
            u32x4 w; w.x = pk2(ya[0], ya[1]); w.y = pk2(ya[2], ya[3]); w.z = pk2(yb[0], yb[1]); w.w = pk2(yb[2], yb[3]);
            *(u32x4*)(ACAT + (size_t)(m0 + tt) * DM + CB + ch0) = w;
        }
    }
}

__device__ __forceinline__ bf16x8 pack8(const f32x16& p, int s) {
    u32x4 w; w.x = pk2(p[8 * s + 0], p[8 * s + 1]); w.y = pk2(p[8 * s + 2], p[8 * s + 3]); w.z = pk2(p[8 * s + 4], p[8 * s + 5]); w.w = pk2(p[8 * s + 6], p[8 * s + 7]);
    return __builtin_bit_cast(bf16x8, w);
}
__device__ __forceinline__ void qk_tile(f32x16& p0, f32x16& p1, const bf16* Krow0, const bf16x8 (&qf)[4], int r32, int h) {
    const bf16* k0 = Krow0 + (size_t)r32 * 128 + 8 * h; const bf16* k1 = k0 + 32 * 128;
    p0 = (f32x16){}; p1 = (f32x16){};
#pragma unroll
    for (int s = 0; s < 4; ++s) {
        const bf16x8 a0 = *(const bf16x8*)(k0 + 16 * s), a1 = *(const bf16x8*)(k1 + 16 * s);
        p0 = __builtin_amdgcn_mfma_f32_32x32x16_bf16(a0, qf[s], p0, 0, 0, 0);
        p1 = __builtin_amdgcn_mfma_f32_32x32x16_bf16(a1, qf[s], p1, 0, 0, 0);
    }
}
__device__ __forceinline__ void pv_tile(f32x16 (&o)[2], const f32x16& p0, const f32x16& p1, const bf16* Vt0, int vlen, int r32, int h) {
#pragma unroll
    for (int blk = 0; blk < 2; ++blk)
#pragma unroll
        for (int s = 0; s < 2; ++s) {
            const bf16x8 pf = pack8(blk ? p1 : p0, s);
#pragma unroll
            for (int db = 0; db < 2; ++db) {
                const bf16x8 vf = *(const bf16x8*)(Vt0 + (size_t)(32 * db + r32) * vlen + 32 * blk + 16 * s + 8 * h);
                o[db] = __builtin_amdgcn_mfma_f32_32x32x16_bf16(vf, pf, o[db], 0, 0, 0);
            }
        }
}
__device__ __forceinline__ void softmax_step(f32x16& p0, f32x16& p1, float& mrun, float& lrun, f32x16 (&o)[2], int lo, int hi) {
    float tm = NEG_BIG;
#pragma unroll
    for (int reg = 0; reg < 16; ++reg) {
        const int c0 = (reg & 3) + 8 * (reg >> 2), c1 = c0 + 32;
        const bool ok0 = (c0 >= lo) & (c0 <= hi), ok1 = (c1 >= lo) & (c1 <= hi);
        p0[reg] = ok0 ? p0[reg] : NEG_BIG; p1[reg] = ok1 ? p1[reg] : NEG_BIG;
        tm = fmaxf(tm, fmaxf(p0[reg], p1[reg]));
    }
    tm = fmaxf(tm, __shfl_xor(tm, 32));
    const float mnew = fmaxf(mrun, tm);
    const float alpha = __builtin_amdgcn_exp2f(mrun - mnew);
    float ls = 0.f;
#pragma unroll
    for (int reg = 0; reg < 16; ++reg) {
        const float x0 = __builtin_amdgcn_exp2f(p0[reg] - mnew), x1 = __builtin_amdgcn_exp2f(p1[reg] - mnew);
        const float e0 = (p0[reg] > 0.5f * NEG_BIG) ? x0 : 0.f, e1 = (p1[reg] > 0.5f * NEG_BIG) ? x1 : 0.f;
        p0[reg] = e0; p1[reg] = e1; ls += e0 + e1;
    }
    lrun = lrun * alpha + ls; mrun = mnew;
#pragma unroll
    for (int reg = 0; reg < 16; ++reg) { o[0][reg] *= alpha; o[1][reg] *= alpha; }
}
__device__ __forceinline__ int crow16(int reg, int h) { return (reg & 3) + 8 * (reg >> 2) + 4 * h; }

__device__ __forceinline__ void attn_task(Frame& F, int ia, int bq, int g, int tg) {
    unsigned char* ws = F.ws;
    const int lane = F.lane, r32 = lane & 31, h = lane >> 5, tq = r32 >> 2, rh = r32 & 3, head = g * 4 + rh;
    const bool prm = bq < NB_P;
    const int t = tg * 8 + tq, m = seq_row0(bq) + t, pos = (prm ? 0 : PAST) + t;
    const bf16* Q = (const bf16*)(ws + WS_Q) + (size_t)m * 512 + head * 64 + 8 * h;
    bf16x8 qf[4];
#pragma unroll
    for (int s = 0; s < 4; ++s) qf[s] = *(const bf16x8*)(Q + 16 * s);
    const float* gt = (const float*)(ws + WS_GATES) + (size_t)m * 24 + head * 3;
    const float gc = gt[0], gs = gt[1], gw = gt[2];
    f32x16 o[2]; f32x16 p0, p1;
    LAS float* park = (LAS float*)(F.lds + F.wave * 8192) + lane;

    unsigned selmask;
    {
        const bf16* Kc = (const bf16*)(ws + WS_KCMP) + ia * KCMP_L + (size_t)bq * 64 * 128 + g * 64;
        qk_tile(p0, p1, Kc, qf, r32, h);
        const int nvalid = min((pos + 1) >> 5, 64);
        float mx = NEG_BIG;
#pragma unroll
        for (int reg = 0; reg < 16; ++reg) { const int n0 = crow16(reg, h); p0[reg] = (n0 < nvalid) ? p0[reg] : NEG_BIG; p1[reg] = (n0 + 32 < nvalid) ? p1[reg] : NEG_BIG; mx = fmaxf(mx, fmaxf(p0[reg], p1[reg])); }
        mx = fmaxf(mx, __shfl_xor(mx, 32));
        float ls = 0.f;
#pragma unroll
        for (int reg = 0; reg < 16; ++reg) {
            const float x0 = __builtin_amdgcn_exp2f(p0[reg] - mx), x1 = __builtin_amdgcn_exp2f(p1[reg] - mx);
            const float e0 = (p0[reg] > 0.5f * NEG_BIG) ? x0 : 0.f, e1 = (p1[reg] > 0.5f * NEG_BIG) ? x1 : 0.f;
            p0[reg] = e0; p1[reg] = e1; ls += e0 + e1;
        }
        ls += __shfl_xor(ls, 32);
        const float inv = ls > 0.f ? 1.0f / ls : 0.f;
#pragma unroll
        for (int reg = 0; reg < 16; ++reg) { p0[reg] *= inv; p1[reg] *= inv; }
        float own[2][4][2], oth[2][4][2];
#pragma unroll
        for (int q = 0; q < 4; ++q)
#pragma unroll
            for (int e = 0; e < 2; ++e) {
                float v0 = p0[4 * q + 2 * e] + p0[4 * q + 2 * e + 1], v1 = p1[4 * q + 2 * e] + p1[4 * q + 2 * e + 1];
                v0 += __shfl_xor(v0, 1); v0 += __shfl_xor(v0, 2); v1 += __shfl_xor(v1, 1); v1 += __shfl_xor(v1, 2);
                own[0][q][e] = v0; own[1][q][e] = v1; oth[0][q][e] = __shfl_xor(v0, 32); oth[1][q][e] = __shfl_xor(v1, 32);
            }
        float imp[32];
#pragma unroll
        for (int blk = 0; blk < 2; ++blk)
#pragma unroll
            for (int q = 0; q < 4; ++q)
#pragma unroll
                for (int hh = 0; hh < 2; ++hh)
#pragma unroll
                    for (int e = 0; e < 2; ++e) imp[16 * blk + 4 * q + 2 * hh + e] = (h == hh) ? own[blk][q][e] : oth[blk][q][e];
        const int cur = prm ? (pos >> 6) : 32;
        const int jmax = prm ? cur - 2 : 30;
        const int nfree = 8 - min(cur + 1, 3);
        imp[0] = -1.f;
#pragma unroll
        for (int j = 1; j < 32; ++j) imp[j] = (j <= jmax) ? imp[j] : -1.f;
        unsigned part = 0u;
        const int rounds = min(nfree, max(jmax, 0));
        for (int rd = 0; rd < 7; ++rd) {
            if (!__any(rd < rounds)) break;
            float mxv = imp[1];
#pragma unroll
            for (int j = 2; j < 32; ++j) mxv = fmaxf(mxv, imp[j]);
            bool found = !(rd < rounds) || !(mxv >= 0.f);
#pragma unroll
            for (int j = 1; j < 32; ++j) { const bool hit = !found && (imp[j] == mxv); found = found || hit; imp[j] = hit ? -1.f : imp[j]; part |= hit ? (1u << j) : 0u; }
        }
        selmask = part | 1u;
        if (prm) { selmask |= 1u << cur; if (cur >= 1) selmask |= 1u << (cur - 1); } else selmask |= 1u << 31;
        o[0] = (f32x16){}; o[1] = (f32x16){};
        const bf16* Vc = (const bf16*)(ws + WS_VCMPT) + ia * KCMP_L + ((size_t)bq * 2 + g) * 64 * 64;
        pv_tile(o, p0, p1, Vc, 64, r32, h);
#pragma unroll
        for (int reg = 0; reg < 16; ++reg) { park[reg * 64] = gc * o[0][reg]; park[(16 + reg) * 64] = gc * o[1][reg]; }
    }
    {
        const bf16* Ks = (const bf16*)(ws + WS_KSEL) + ia * KSEL_L + (size_t)bq * KLEN * 128 + g * 64;
        const bf16* Vs = (const bf16*)(ws + WS_VSELT) + ia * KSEL_L + ((size_t)bq * 2 + g) * 64 * KLEN;
        float mrun = NEG_BIG, lrun = 0.f; o[0] = (f32x16){}; o[1] = (f32x16){};
        const int jt_end = prm ? ((tg * 8 + 7) >> 6) : 32;
        for (int jt = 0; jt <= jt_end; ++jt) {
            const bool mine = (jt < 32) ? ((selmask >> jt) & 1u) != 0u : true;
            if (!__any(mine)) continue;
            qk_tile(p0, p1, Ks + (size_t)jt * 64 * 128, qf, r32, h);
            const int kbase = 64 * jt + 4 * h;
            softmax_step(p0, p1, mrun, lrun, o, -1000, mine ? pos - kbase : -1);
            pv_tile(o, p0, p1, Vs + 64 * jt, KLEN, r32, h);
        }
        lrun += __shfl_xor(lrun, 32);
        const float sc = lrun > 0.f ? gs / lrun : 0.f;
#pragma unroll
        for (int reg = 0; reg < 16; ++reg) { park[reg * 64] += sc * o[0][reg]; park[(16 + reg) * 64] += sc * o[1][reg]; }
    }
    {
        const int wbase = prm ? 0 : 1536;
        const int wi = pos - wbase;
        const bf16* Kw = (const bf16*)(ws + WS_KWIN) + ia * KWIN_L + kwin_row0(bq) * 128 + g * 64;
        int vlen; const size_t vb = vwint_base(bq, g, vlen);
        const bf16* Vw = (const bf16*)(ws + WS_VWINT) + ia * KWIN_L + vb;
        float mrun = NEG_BIG, lrun = 0.f; o[0] = (f32x16){}; o[1] = (f32x16){};
        const int wi_lo = (prm ? 0 : PAST - 1536) + tg * 8, wi_hi = wi_lo + 7;
        const int jt0 = max(wi_lo - (WB - 1), 0) >> 6, jt1 = wi_hi >> 6;
        for (int jt = jt0; jt <= jt1; ++jt) {
            qk_tile(p0, p1, Kw + (size_t)jt * 64 * 128, qf, r32, h);
            const int kbase = 64 * jt + 4 * h;
            softmax_step(p0, p1, mrun, lrun, o, wi - (WB - 1) - kbase, wi - kbase);
            pv_tile(o, p0, p1, Vw + 64 * jt, vlen, r32, h);
        }
        lrun += __shfl_xor(lrun, 32);
        const float sc = lrun > 0.f ? gw / lrun : 0.f;
#pragma unroll
        for (int reg = 0; reg < 16; ++reg) { o[0][reg] = park[reg * 64] + sc * o[0][reg]; o[1][reg] = park[(16 + reg) * 64] + sc * o[1][reg]; }
    }
    bf16* O = (bf16*)(ws + WS_ACAT) + (size_t)m * DM + head * 64 + 4 * h;
#pragma unroll
    for (int db = 0; db < 2; ++db)
#pragma unroll
        for (int q = 0; q < 4; ++q) { u32x2 w; w.x = pk2(o[db][4 * q], o[db][4 * q + 1]); w.y = pk2(o[db][4 * q + 2], o[db][4 * q + 3]); *(u32x2*)(O + 32 * db + 8 * q) = w; }
}
constexpr int ATT_TASKS = NB_S * 2 + NB_P * 2 * (SEQ / 8);
__device__ __forceinline__ void a3_attention(Frame& F, int ia) {
    unsigned* ctr = F.ctl + CW_ATT + 64 * ia;
    for (;;) {
        unsigned idx = 0;
        if (F.lane == 0) idx = __hip_atomic_fetch_add(ctr, 1u, __ATOMIC_RELAXED, __HIP_MEMORY_SCOPE_AGENT);
        idx = (unsigned)__builtin_amdgcn_readfirstlane((int)idx);
        if (idx >= (unsigned)ATT_TASKS) break;
        if (idx < (unsigned)(NB_S * 2)) { attn_task(F, ia, NB_P + (int)(idx >> 1), (int)(idx & 1), 0); }
        else { const int p = (int)idx - NB_S * 2; const int chunkrev = p >> 7, bg = (p >> 3) & 15, w = p & 7;
               attn_task(F, ia, bg >> 1, bg & 1, 8 * (31 - chunkrev) + (7 - w)); }
    }
}

__device__ __forceinline__ void ln_phase(Frame& F, const float* gam, const float* bet, float* dstf, bool write_xb) {
    unsigned char* ws = F.ws;
    const float* V = (const float*)(ws + WS_V); bf16* XB = (bf16*)(ws + WS_XB);
    f32x4 gv[4], bv[4];
#pragma unroll
    for (int j = 0; j < 4; ++j) { gv[j] = *((const f32x4*)gam + F.lane + 64 * j); bv[j] = *((const f32x4*)bet + F.lane + 64 * j); }
    for (int m = F.gw; m < M; m += F.NGW) {
        const f32x4* xr = (const f32x4*)(V + (size_t)m * DM) + F.lane;
        f32x4 v[4]; float s = 0.f;
#pragma unroll
        for (int j = 0; j < 4; ++j) { v[j] = xr[64 * j]; s += (v[j][0] + v[j][1]) + (v[j][2] + v[j][3]); }
        const float mean = wave_sum(s) * (1.f / DM); float s2 = 0.f;
#pragma unroll
        for (int j = 0; j < 4; ++j) { v[j] = v[j] - mean; s2 += (v[j][0] * v[j][0] + v[j][1] * v[j][1]) + (v[j][2] * v[j][2] + v[j][3] * v[j][3]); }
        const float rstd = 1.0f / sqrtf(wave_sum(s2) * (1.f / DM) + LN_EPS);
#pragma unroll
        for (int j = 0; j < 4; ++j) { const f32x4 y = v[j] * rstd * gv[j] + bv[j]; *((f32x4*)(dstf + (size_t)m * DM) + F.lane + 64 * j) = y;
            if (write_xb) { u32x2 w; w.x = pk2(y[0], y[1]); w.y = pk2(y[2], y[3]); *((u32x2*)(XB + (size_t)m * DM) + F.lane + 64 * j) = w; } }
    }
}

__device__ __forceinline__ void c2_pool(Frame& F, int ic) {
    unsigned char* ws = F.ws;
    const float* UC = (const float*)(ws + WS_UC); bf16* D = (bf16*)(ws + WS_D);
    for (int m = F.gw; m < M; m += F.NGW) {
        int bq, t, pos; row_info(m, bq, t, pos);
        const bool prm = m < MP;
        const float* hist = prm ? nullptr : F.in[I_SPOOL] + ((size_t)ic * NB_S + (bq - NB_P)) * PHIST * DM;
        float* po = nullptr;
        if (prm) { if (t >= SEQ - PHIST) po = F.out + O_POOLP + (((size_t)ic * NB_P + bq) * PHIST + (t - (SEQ - PHIST))) * DM; }
        else po = F.out + O_POOLS + (((size_t)ic * NB_S + (bq - NB_P)) * PHIST + 7 + t) * DM;
#pragma unroll
        for (int gi = 0; gi < 4; ++gi) {
            const int w = 2 << gi, ch = gi * 256 + 4 * F.lane;
            const f32x4 u0 = *(const f32x4*)(UC + (size_t)m * DM + ch);
            f32x4 s = u0;
            for (int k = 1; k < w; ++k) { const int tau = t - k;
                if (tau >= 0) s += *(const f32x4*)(UC + (size_t)(m - k) * DM + ch);
                else if (hist) s += *(const f32x4*)(hist + (size_t)(PHIST + tau) * DM + ch); }
            const float cnt = (float)min(pos + 1, w);
            const f32x4 d = s * (1.0f / cnt) - u0;
            u32x2 o; o.x = pk2(d[0], d[1]); o.y = pk2(d[2], d[3]); *(u32x2*)(D + (size_t)m * DM + ch) = o;
            if (po) *(f32x4*)(po + ch) = u0;
        }
    }
}

__global__ void __launch_bounds__(NWAVES * 64, 2) nsa_fwd(Args args) {
    extern __shared__ __attribute__((aligned(16))) unsigned char lds[];
    Frame F;
    F.lds = (LAS unsigned char*)lds;
    F.tid = threadIdx.x; F.lane = F.tid & 63; F.wave = __builtin_amdgcn_readfirstlane(F.tid >> 6);
    F.G = gridDim.x; F.gw = blockIdx.x * NWAVES + F.wave; F.NGW = F.G * NWAVES;
    F.in = args.in; F.out = args.out; F.ws = args.ws; F.ctl = (unsigned*)(args.ws + WS_CTL);
    unsigned char* ws = args.ws;
    for (int u = F.tid; u < (LDS_BYTES - LDSCTL_OFF) / 4; u += NWAVES * 64) ((LAS unsigned*)(F.lds + LDSCTL_OFF))[u] = 0u;
    __syncthreads();
#if MK_ONE_LAUNCH
    XcdBarrier bar = xcd_barrier_post(F.ctl + CW_BAR, (volatile LAS unsigned*)(F.lds + MISC_OFF) + 8);
#define GRID_BAR() xcd_barrier(bar)
#else
#define GRID_BAR() do { } while (0)
#endif
    const int lo = args.ph_lo, hi = args.ph_hi;
    int ph = 0;
#define PHASE_BEGIN if (lo <= ph && ph < hi) { { int t_ = threadIdx.x; asm volatile("" : "+v"(t_)); F.tid = t_; F.lane = t_ & 63; }
#define PHASE_END   if (ph + 1 < hi) GRID_BAR(); } ++ph;

    PHASE_BEGIN
        if PHON(0) p0_weights(F);
        if PHON(1) p0_misc(F);
        __syncthreads();
    PHASE_END
    PHASE_BEGIN
        if PHON(2) p0_sample_state(F);
        __syncthreads();
    PHASE_END

    for (int l = 0; l < 4; ++l) {
        const int half = l >> 1;
        const bool even = (l & 1) == 0;
        PHASE_BEGIN
            pg8::Gemm g{(const bf16*)(ws + WS_XB), even ? (const bf16*)(ws + WS_WA) + (size_t)half * IN_A_PAD * DM : (const bf16*)(ws + WS_WCIN) + (size_t)half * DM * DM, M, even ? IN_A_PAD : DM, DM, DM, DM, 0};
            pg8::StaticOrder S; S.init(M, g.N, F.G, (int)blockIdx.x);
            pg8::EpiF32 E{even ? (float*)(ws + WS_H) : (float*)(ws + WS_UC), even ? IN_A_PAD : DM};
            if PHON(3) pg8::gemm_phase<pg8::EpiF32, pg8::StaticOrder, true, true>(F.lds, g, S, E);
        PHASE_END
        if (even) {
            PHASE_BEGIN if PHON(4) a1_post(F, half); PHASE_END
            PHASE_BEGIN if PHON(5) a2_compress_prompt(F, half); if PHON(6) a2_conv(F, half); PHASE_END
            PHASE_BEGIN if PHON(7) a3_attention(F, half); PHASE_END
        } else {
            PHASE_BEGIN if PHON(8) c2_pool(F, half); PHASE_END
            PHASE_BEGIN
                pg8::Gemm g{(const bf16*)(ws + WS_D), (const bf16*)(ws + WS_WG) + (size_t)half * DM * DM, M, DM, 256, DM, DM, 512};
                pg8::StaticOrder S; S.init(M, DM, F.G, (int)blockIdx.x);
                pg8::EpiScaleBf16 E{(bf16*)(ws + WS_Z), DM, F.in[I_SCALEC] + half * DM};
                if PHON(9) pg8::gemm_phase<pg8::EpiScaleBf16, pg8::StaticOrder, true, true>(F.lds, g, S, E);
            PHASE_END
        }
        PHASE_BEGIN
            pg8::Gemm g{even ? (const bf16*)(ws + WS_ACAT) : (const bf16*)(ws + WS_Z), even ? (const bf16*)(ws + WS_WO) + (size_t)half * DM * DM : (const bf16*)(ws + WS_WCOUT) + (size_t)half * DM * DM, M, DM, DM, DM, DM, 0};
            pg8::StaticOrder S; S.init(M, DM, F.G, (int)blockIdx.x);
            pg8::EpiRes E{(const float*)(ws + WS_XF), (float*)(ws + WS_V), ALPHA};
            if PHON(10) pg8::gemm_phase<pg8::EpiRes, pg8::StaticOrder, true, true>(F.lds, g, S, E);
        PHASE_END
        PHASE_BEGIN if PHON(11) ln_phase(F, F.in[I_LN1G] + l * DM, F.in[I_LN1B] + l * DM, (float*)(ws + WS_XF), true); PHASE_END
        PHASE_BEGIN
            pg8::Gemm g{(const bf16*)(ws + WS_XB), (const bf16*)(ws + WS_W13) + (size_t)l * 2 * DFF * DM, M, 2 * DFF, DM, DM, DM, 0};
            pg8::StaticOrder S; S.init(M, 2 * DFF, F.G, (int)blockIdx.x);
            pg8::EpiSwiglu E{(bf16*)(ws + WS_HF), DFF};
            if PHON(12) pg8::gemm_phase<pg8::EpiSwiglu, pg8::StaticOrder, true, true>(F.lds, g, S, E);
        PHASE_END
        PHASE_BEGIN
            pg8::Gemm g{(const bf16*)(ws + WS_HF), (const bf16*)(ws + WS_W2) + (size_t)l * DM * DFF, M, DM, DFF, DFF, DFF, 0};
            pg8::StaticOrder S; S.init(M, DM, F.G, (int)blockIdx.x);
            pg8::EpiRes E{(const float*)(ws + WS_XF), (float*)(ws + WS_V), ALPHA};
            if PHON(13) pg8::gemm_phase<pg8::EpiRes, pg8::StaticOrder, true, true>(F.lds, g, S, E);
        PHASE_END
        PHASE_BEGIN if PHON(14) ln_phase(F, F.in[I_LN2G] + l * DM, F.in[I_LN2B] + l * DM, l == 3 ? F.out + O_Y : (float*)(ws + WS_XF), l != 3); PHASE_END
    }
}
constexpr int N_PHASES = 2 + 2 * 9 + 2 * 8;

extern "C" void kernel_launch(void* const* d_in, const int* in_sizes, int n_in, void* d_out, int out_size, void* d_ws, size_t ws_size, hipStream_t stream) {
    static int grid = 0;
    if (grid == 0) {
        if (n_in != N_IN || (size_t)out_size != O_END || ws_size < WS_END) { fprintf(stderr, "kernel_launch: unexpected sizes n_in %d out %d ws %zu (need %zu)\n", n_in, out_size, ws_size, (size_t)WS_END); grid = -1; return; }
        int dev = 0, cus = 0, per_cu = 0;
        if (hipGetDevice(&dev) != hipSuccess || hipDeviceGetAttribute(&cus, hipDeviceAttributeMultiprocessorCount, dev) != hipSuccess) { grid = -1; return; }
        if (hipFuncSetAttribute((const void*)nsa_fwd, hipFuncAttributeMaxDynamicSharedMemorySize, LDS_BYTES) != hipSuccess) { fprintf(stderr, "kernel_launch: hipFuncSetAttribute failed\n"); grid = -1; return; }
        if (hipOccupancyMaxActiveBlocksPerMultiprocessor(&per_cu, (const void*)nsa_fwd, NWAVES * 64, LDS_BYTES) != hipSuccess || per_cu < 1) fprintf(stderr, "kernel_launch: occupancy query says %d\n", per_cu);
        (void)hipGetLastError();
        grid = cus;
    }
    if (grid < 0) return;
    (void)hipMemsetAsync((char*)d_ws + WS_CTL, 0, CTL_ZERO_BYTES, stream);
    Args a{};
    for (int i = 0; i < N_IN; ++i) a.in[i] = (const float*)d_in[i];
    a.out = (float*)d_out; a.ws = (unsigned char*)d_ws;
#if MK_ONE_LAUNCH
    a.ph_lo = 0; a.ph_hi = N_PHASES;
    hipLaunchKernelGGL(nsa_fwd, dim3(grid), dim3(NWAVES * 64), LDS_BYTES, stream, a);
#else
    for (int p = 0; p < N_PHASES; ++p) { a.ph_lo = p; a.ph_hi = p + 1; hipLaunchKernelGGL(nsa_fwd, dim3(grid), dim3(NWAVES * 64), LDS_BYTES, stream, a); }
#endif
}
```

```cpp
#include <hip/hip_runtime.h>
#include <cstdio>
#include <cstdint>

#ifndef PHMASK
#define PHMASK 0xFFFFF
#endif
#define PHON(k) constexpr (((PHMASK) >> (k)) & 1)
#ifndef MK_ONE_LAUNCH
#define MK_ONE_LAUNCH 1
#endif

#define GAS __attribute__((address_space(1)))
#define LAS __attribute__((address_space(3)))
typedef unsigned short bf16;
typedef float f32x4 __attribute__((ext_vector_type(4)));
typedef float f32x16 __attribute__((ext_vector_type(16)));
typedef short bf16x8 __attribute__((ext_vector_type(8)));
typedef unsigned u32x4 __attribute__((ext_vector_type(4)));
typedef unsigned u32x2 __attribute__((ext_vector_type(2)));
typedef float f32x2_t __attribute__((ext_vector_type(2)));
typedef __bf16 bf16x2_t __attribute__((ext_vector_type(2)));

constexpr int DM = 1024, NB_P = 8, SEQ = 2048, NB_S = 128, DSEQ = 8, PAST = 2048, PAGE = 128, NPAGES = 16, NPOOLPG = 2560;
constexpr int MP = NB_P * SEQ, MS = NB_S * DSEQ, M = MP + MS;
constexpr int NSEQ = NB_P + NB_S;
constexpr int HD = 64, NH = 8, KVH = 2;
constexpr int IN_A = 2328, IN_A_PAD = 2560, CB = 512, CONVW = 31, DFF = 2816, WB = 512, PHIST = 15;
constexpr int KLEN = 2112;
constexpr int WLEN_S = 576;
constexpr float LN_EPS = 1e-5f;
constexpr float ALPHA = 1.681792830507429f;
constexpr float C2 = 0.125f * 1.4426950408889634f;
constexpr float NEG_BIG = -1.0e30f;

enum { I_XP = 0, I_XS, I_CACHE, I_SWIN, I_SCONV, I_SPOOL, I_PT, I_WINA, I_WCK, I_PECK, I_WCV, I_PECV, I_CONVW, I_CONVB, I_CLNG, I_CLNB,
       I_WOUTA, I_WINC, I_WGRP, I_SCALEC, I_WOUTC, I_LN1G, I_LN1B, I_LN2G, I_LN2B, I_W1, I_W3, I_W2, N_IN };
constexpr size_t O_Y = 0;
constexpr size_t O_KVP = (size_t)M * DM;
constexpr size_t O_KVS = O_KVP + (size_t)2 * MP * 512;
constexpr size_t O_WINP = O_KVS + (size_t)2 * MS * 512;
constexpr size_t O_WINS = O_WINP + (size_t)2 * NB_P * WB * 256;
constexpr size_t O_CONVP = O_WINS + (size_t)2 * NB_S * WB * 256;
constexpr size_t O_CONVS = O_CONVP + (size_t)2 * NB_P * 30 * CB;
constexpr size_t O_POOLP = O_CONVS + (size_t)2 * NB_S * 30 * CB;
constexpr size_t O_POOLS = O_POOLP + (size_t)2 * NB_P * PHIST * DM;
constexpr size_t O_END = O_POOLS + (size_t)2 * NB_S * PHIST * DM;
static_assert(O_END == 79659008, "output size");

constexpr size_t al256(size_t x) { return (x + 255) & ~(size_t)255; }
constexpr size_t WS_CTL = 0, CTL_ZERO_BYTES = 1u << 20;
constexpr size_t WS_WA = CTL_ZERO_BYTES;
constexpr size_t WS_WO = WS_WA + (size_t)2 * IN_A_PAD * DM * 2;
constexpr size_t WS_WCIN = WS_WO + (size_t)2 * DM * DM * 2;
constexpr size_t WS_WCOUT = WS_WCIN + (size_t)2 * DM * DM * 2;
constexpr size_t WS_WG = WS_WCOUT + (size_t)2 * DM * DM * 2;
constexpr size_t WS_W13 = WS_WG + (size_t)2 * DM * DM * 2;
constexpr size_t WS_W2 = WS_W13 + (size_t)4 * 2 * DFF * DM * 2;
constexpr size_t WS_WCMP = WS_W2 + (size_t)4 * DM * DFF * 2;
constexpr size_t WS_BIASC = WS_WCMP + (size_t)4 * 64 * 2048 * 2;
constexpr size_t WS_ROPE = al256(WS_BIASC + 4 * 64 * 4);
constexpr size_t WS_XF = al256(WS_ROPE + (size_t)KLEN * 32 * 2 * 4);
constexpr size_t WS_XB = WS_XF + (size_t)M * DM * 4;
constexpr size_t WS_H = WS_XB + (size_t)M * DM * 2;
constexpr size_t WS_Q = WS_H + (size_t)M * IN_A_PAD * 4;
constexpr size_t WS_KSEL = WS_Q + (size_t)M * 512 * 2;
constexpr size_t KSEL_L = (size_t)NSEQ * KLEN * 128;
constexpr size_t WS_VSELT = WS_KSEL + 2 * KSEL_L * 2;
constexpr size_t WS_KWIN = WS_VSELT + 2 * KSEL_L * 2;
constexpr size_t WROWS = (size_t)MP + (size_t)NB_S * WLEN_S;
constexpr size_t KWIN_L = WROWS * 128;
constexpr size_t WS_VWINT = WS_KWIN + 2 * KWIN_L * 2;
constexpr size_t WS_KCMP = WS_VWINT + 2 * KWIN_L * 2;
constexpr size_t KCMP_L = (size_t)NSEQ * 64 * 128;
constexpr size_t WS_VCMPT = WS_KCMP + 2 * KCMP_L * 2;
constexpr size_t WS_GATES = WS_VCMPT + 2 * KCMP_L * 2;
constexpr size_t WS_U = al256(WS_GATES + (size_t)M * 24 * 4);
constexpr size_t WS_ACAT = WS_U + (size_t)M * CB * 4;
constexpr size_t WS_V = WS_ACAT + (size_t)M * DM * 2;
constexpr size_t WS_HF = WS_V + (size_t)M * DM * 4;
constexpr size_t WS_UC = WS_HF + (size_t)M * DFF * 2;
constexpr size_t WS_D = WS_UC + (size_t)M * DM * 4;
constexpr size_t WS_Z = WS_D + (size_t)M * DM * 2;
constexpr size_t WS_END = WS_Z + (size_t)M * DM * 2;
constexpr int CW_ATT = 64;
constexpr int CW_BAR = 4096;

constexpr int RING_BYTES = 131072, LDSCTL_OFF = RING_BYTES, MISC_OFF = LDSCTL_OFF + 320, LDS_BYTES = 147456;
constexpr int NWAVES = 8;

__device__ __forceinline__ unsigned pk2(float lo, float hi) { f32x2_t v = {lo, hi}; bf16x2_t b = __builtin_convertvector(v, bf16x2_t); return __builtin_bit_cast(unsigned, b); }
__device__ __forceinline__ bf16 f2bf(float f) { return (bf16)(pk2(f, 0.f) & 0xffffu); }
__device__ __forceinline__ float wave_sum(float v) {
#pragma unroll
    for (int o = 1; o < 64; o <<= 1) v += __shfl_xor(v, o);
    return v;
}
__device__ __forceinline__ float sigmoidf_(float x) { return __builtin_amdgcn_rcpf(1.f + __expf(-x)); }
__device__ __forceinline__ int vt_col(int t) { const int x = t & 15; return (t & ~15) | (x & 3) | ((x & 4) << 1) | ((x & 8) >> 1); }
#define LDS_WAIT() asm volatile("s_waitcnt lgkmcnt(0)" ::: "memory")
#define VM_WAIT() asm volatile("s_waitcnt vmcnt(0)" ::: "memory")

namespace pg8 {
#define PG8_LAS __attribute__((address_space(3)))
typedef unsigned short bf16_t;
constexpr int BM = 256, BK = 64, HALF = 128, HTB = HALF * BK * 2, STAGE_BYTES = 8 * HTB, NXCD = 8, WGM = 8;
__host__ __device__ __forceinline__ int lds_byte(int r, int c) { const int st = (r >> 4) * 2 + (c >> 5), rr = r & 15, cc = c & 31, ob = rr * 64 + cc * 2; return st * 1024 + (ob ^ (((ob >> 9) & 1) << 5)); }
__host__ __device__ __forceinline__ void stage_rc(int b, int& R, int& C) { const int st = b / 1024, sb = b % 1024, swz = sb ^ (((sb >> 9) & 1) << 5); R = (st >> 1) * 16 + swz / 64; C = (st & 1) * 32 + (swz % 64) / 2; }
__host__ __device__ __forceinline__ int perm32(int rho) { const int n = rho >> 4, i = rho & 15; return 8 * (i >> 2) + 4 * n + (i & 3); }
struct Unit { int pm, pn; };
struct Gemm { const bf16_t* A; const bf16_t* Bt; int M, N, K, lda, ldb; size_t pn_koff; };
struct StaticOrder {
    int nM, nN, nwg, G, c;
    __host__ __device__ void init(int M, int N, int G_, int c_) { nM = M / BM; nN = N / BM; nwg = nM * nN; G = G_; c = c_; }
    __host__ __device__ bool next(int i, Unit& u) const {
        const long L = (long)i * G + c; if (L >= nwg) return false;
        int wgid = (int)L; { const int q = nwg / NXCD, r = nwg % NXCD, xcd = wgid % NXCD, off = wgid / NXCD; wgid = (xcd < r ? xcd * (q + 1) : r * (q + 1) + (xcd - r) * q) + off; }
        const int nig = WGM * nN, gid = wgid / nig, fm = gid * WGM, gsz = (nM - fm) < WGM ? (nM - fm) : WGM;
        u.pm = fm + ((wgid % nig) % gsz); u.pn = (wgid % nig) / gsz; return true;
    }
    __device__ __forceinline__ void a_ready(const Unit&) const {}
    __device__ __forceinline__ void done(const Unit&) const {}
};
struct EpiF32 {
    static constexpr bool PERM = false;
    float* O; int ldc;
    __device__ __forceinline__ void operator()(const f32x4 (&acc)[2][2][4][2], const Unit& u, int wr, int wc, int fr, int fq) const {
        const int row0 = u.pm * BM + wr * 64 + fr, col0 = u.pn * BM + wc * 32 + 4 * fq;
#pragma unroll
        for (int ai = 0; ai < 2; ++ai)
#pragma unroll
            for (int m = 0; m < 4; ++m) { float* rowp = O + (size_t)(row0 + ai * HALF + m * 16) * ldc + col0;
#pragma unroll
                for (int bj = 0; bj < 2; ++bj)
#pragma unroll
                    for (int n = 0; n < 2; ++n) *(f32x4*)(rowp + bj * HALF + n * 16) = acc[ai][bj][m][n]; }
    }
};
struct EpiRes {
    static constexpr bool PERM = false;
    const float* X; float* V; float alpha;
    __device__ __forceinline__ void operator()(const f32x4 (&acc)[2][2][4][2], const Unit& u, int wr, int wc, int fr, int fq) const {
        const int row0 = u.pm * BM + wr * 64 + fr, col0 = u.pn * BM + wc * 32 + 4 * fq;
#pragma unroll
        for (int ai = 0; ai < 2; ++ai)
#pragma unroll
            for (int m = 0; m < 4; ++m) { const size_t off = (size_t)(row0 + ai * HALF + m * 16) * 1024 + col0;
#pragma unroll
                for (int bj = 0; bj < 2; ++bj)
#pragma unroll
                    for (int n = 0; n < 2; ++n) { const f32x4 x = *(const f32x4*)(X + off + bj * HALF + n * 16); *(f32x4*)(V + off + bj * HALF + n * 16) = x * alpha + acc[ai][bj][m][n]; } }
    }
};
struct EpiScaleBf16 {
    static constexpr bool PERM = true;
    bf16_t* O; int ldc; const float* scale;
    __device__ __forceinline__ void operator()(const f32x4 (&acc)[2][2][4][2], const Unit& u, int wr, int wc, int fr, int fq) const {
        const int row0 = u.pm * BM + wr * 64 + fr, col0 = u.pn * BM + wc * 32 + 8 * fq;
#pragma unroll
        for (int bj = 0; bj < 2; ++bj) {
            const f32x4 sv0 = *(const f32x4*)(scale + col0 + bj * HALF), sv1 = *(const f32x4*)(scale + col0 + bj * HALF + 4);
#pragma unroll
            for (int ai = 0; ai < 2; ++ai)
#pragma unroll
                for (int m = 0; m < 4; ++m) { bf16_t* rowp = O + (size_t)(row0 + ai * HALF + m * 16) * ldc + col0;
                    const f32x4 v0 = acc[ai][bj][m][0] * sv0, v1 = acc[ai][bj][m][1] * sv1;
                    u32x4 w; w.x = pk2(v0[0], v0[1]); w.y = pk2(v0[2], v0[3]); w.z = pk2(v1[0], v1[1]); w.w = pk2(v1[2], v1[3]);
                    *(u32x4*)(rowp + bj * HALF) = w; asm volatile("" ::: "memory"); }
        }
    }
};
struct EpiSwiglu {
    static constexpr bool PERM = true;
    bf16_t* O; int ldc;
    __device__ __forceinline__ void operator()(const f32x4 (&acc)[2][2][4][2], const Unit& u, int wr, int wc, int fr, int fq) const {
        const int row0 = u.pm * BM + wr * 64 + fr, col0 = u.pn * HALF + wc * 32 + 8 * fq;
#pragma unroll
        for (int ai = 0; ai < 2; ++ai)
#pragma unroll
            for (int m = 0; m < 4; ++m) { bf16_t* rowp = O + (size_t)(row0 + ai * HALF + m * 16) * ldc + col0;
                float h[8];
#pragma unroll
                for (int n = 0; n < 2; ++n)
#pragma unroll
                    for (int j = 0; j < 4; ++j) { const float a = acc[ai][0][m][n][j], b = acc[ai][1][m][n][j]; h[4 * n + j] = a * __builtin_amdgcn_rcpf(1.f + __expf(-a)) * b; }
                u32x4 w; w.x = pk2(h[0], h[1]); w.y = pk2(h[2], h[3]); w.z = pk2(h[4], h[5]); w.w = pk2(h[6], h[7]);
                *(u32x4*)rowp = w; }
    }
};

template <class Epi, class Sched, bool ALIGN_EPI = false, bool SP2 = false>
__device__ __forceinline__ void gemm_phase(PG8_LAS unsigned char* lds, const Gemm g, const Sched& S, const Epi& E) {
    int tid_ = threadIdx.x; asm volatile("" : "+v"(tid_));
    const int tid = tid_, wid = __builtin_amdgcn_readfirstlane(tid >> 6), lane = tid & 63, wr = wid >> 2, wc = wid & 3, fr = lane & 15, fq = lane >> 4;
    int K_ = g.K; asm volatile("" : "+s"(K_));
    const int K = K_, nt = K / BK;
    unsigned voffA[2], voffB[2];
#pragma unroll
    for (int i = 0; i < 2; ++i) { int R, C; stage_rc(tid * 16 + i * 8192, R, C); const int Rb = Epi::PERM ? ((R & ~31) + perm32(R & 31)) : R;
        voffA[i] = (unsigned)(R * g.lda + C) * 2u; voffB[i] = (unsigned)(Rb * g.ldb + C) * 2u; }
    const size_t kstep = (size_t)(BK * 2);
    const size_t hstepA = (size_t)HALF * g.lda * 2, hstepB = (size_t)HALF * g.ldb * 2;
    const size_t tstepA = 2 * hstepA, tstepB = 2 * hstepB;
    const unsigned ldsw = (unsigned)wid * 1024u;
    const int aoff = lds_byte(wr * 64 + fr, fq * 8), boff = lds_byte(wc * 32 + fr, fq * 8);
#define PG8_SA(b, h) (((b) * 2 + (h)) * HTB)
#define PG8_SB(b, h) ((4 + (b) * 2 + (h)) * HTB)
#define PG8_STAGE(bufoff, gbase, voff) do { _Pragma("unroll") for (int _i = 0; _i < 2; ++_i) \
        __builtin_amdgcn_global_load_lds((const unsigned*)((const char*)(gbase) + (voff)[_i]), (PG8_LAS unsigned*)(lds + (bufoff) + ldsw + _i * 8192), 16, 0, 0); } while (0)
#define PG8_LDA(dst, b, h) do { _Pragma("unroll") for (int m = 0; m < 4; ++m) _Pragma("unroll") for (int k = 0; k < 2; ++k) dst[m][k] = *(const PG8_LAS bf16x8*)(lds + PG8_SA(b, h) + aoff + m * 2048 + k * 1024); } while (0)
#define PG8_LDB(dst, b, h) do { _Pragma("unroll") for (int n = 0; n < 2; ++n) _Pragma("unroll") for (int k = 0; k < 2; ++k) dst[n][k] = *(const PG8_LAS bf16x8*)(lds + PG8_SB(b, h) + boff + n * 2048 + k * 1024); } while (0)
#define PG8_MMA(ai, bj, At, Bt) do { __builtin_amdgcn_s_setprio(1); _Pragma("unroll") for (int m = 0; m < 4; ++m) _Pragma("unroll") for (int n = 0; n < 2; ++n) _Pragma("unroll") for (int k = 0; k < 2; ++k) \
        acc[ai][bj][m][n] = __builtin_amdgcn_mfma_f32_16x16x32_bf16(Bt[n][k], At[m][k], acc[ai][bj][m][n], 0, 0, 0); __builtin_amdgcn_s_setprio(0); } while (0)
#define PG8_WAIT_V(n) asm volatile("s_waitcnt vmcnt(" #n ")" ::: "memory")
#define PG8_WAIT_L(n) asm volatile("s_waitcnt lgkmcnt(" #n ")" ::: "memory")
#define PG8_BAR __builtin_amdgcn_s_barrier()
#define PG8_SCHED __builtin_amdgcn_sched_barrier(0)
    Unit cur, nxt; int ui = 0;
    if (!S.next(0, cur)) return;
    f32x4 acc[2][2][4][2];
#pragma unroll
    for (int a = 0; a < 2; ++a)
#pragma unroll
        for (int b = 0; b < 2; ++b)
#pragma unroll
            for (int m = 0; m < 4; ++m)
#pragma unroll
                for (int n = 0; n < 2; ++n) acc[a][b][m][n] = (f32x4){0.f, 0.f, 0.f, 0.f};
    bf16x8 At[4][2], B0[2][2], B1[2][2];
    const char* cA = (const char*)g.A + (size_t)cur.pm * tstepA + (size_t)cur.pn * g.pn_koff; const char* cB = (const char*)g.Bt + (size_t)cur.pn * (tstepB + g.pn_koff);
    S.a_ready(cur);
    if constexpr (SP2) {
        PG8_STAGE(PG8_SB(0, 0), cB, voffB); PG8_STAGE(PG8_SB(0, 1), cB + hstepB, voffB); PG8_STAGE(PG8_SA(0, 0), cA, voffA); PG8_STAGE(PG8_SA(0, 1), cA + hstepA, voffA);
        if (wr == 1) PG8_BAR;
        PG8_WAIT_V(2); PG8_BAR;
        PG8_STAGE(PG8_SB(1, 0), cB + kstep, voffB); PG8_STAGE(PG8_SA(1, 0), cA + kstep, voffA); PG8_STAGE(PG8_SB(1, 1), cB + hstepB + kstep, voffB);
        PG8_WAIT_V(6); PG8_BAR;
    } else {
        PG8_STAGE(PG8_SB(0, 0), cB, voffB); PG8_STAGE(PG8_SA(0, 0), cA, voffA); PG8_STAGE(PG8_SB(0, 1), cB + hstepB, voffB); PG8_STAGE(PG8_SA(0, 1), cA + hstepA, voffA);
        if (wr == 1) PG8_BAR;
        PG8_WAIT_V(4); PG8_BAR;
        PG8_STAGE(PG8_SB(1, 0), cB + kstep, voffB); PG8_STAGE(PG8_SA(1, 0), cA + kstep, voffA); PG8_STAGE(PG8_SB(1, 1), cB + hstepB + kstep, voffB);
        PG8_WAIT_V(6); PG8_BAR;
    }
    for (;;) {
        const bool has_next = S.next(ui + 1, nxt);
        const char* nA = has_next ? (const char*)g.A + (size_t)nxt.pm * tstepA + (size_t)nxt.pn * g.pn_koff : cA; const char* nB = has_next ? (const char*)g.Bt + (size_t)nxt.pn * (tstepB + g.pn_koff) : cB;
        for (int t = 0; t < nt; t += 2) {
            const bool last = (t == nt - 2);
            const char* a1 = cA + (size_t)(t + 1) * kstep;
            const char* a2 = last ? nA : cA + (size_t)(t + 2) * kstep; const char* b2 = last ? nB : cB + (size_t)(t + 2) * kstep;
            const char* a3 = a2 + kstep; const char* b3 = b2 + kstep;
            if (last && has_next) S.a_ready(nxt);
            if constexpr (SP2) {
            PG8_LDB(B0, 0, 0); PG8_LDB(B1, 0, 1); PG8_SCHED; PG8_LDA(At, 0, 0); PG8_STAGE(PG8_SA(1, 1), a1 + hstepA, voffA);
            PG8_WAIT_V(8); PG8_WAIT_L(0); PG8_BAR; PG8_MMA(0, 0, At, B0); PG8_MMA(0, 1, At, B1); PG8_BAR; PG8_SCHED;
            PG8_LDA(At, 0, 1); PG8_STAGE(PG8_SB(0, 0), b2, voffB); PG8_STAGE(PG8_SB(0, 1), b2 + hstepB, voffB); PG8_STAGE(PG8_SA(0, 0), a2, voffA);
            PG8_WAIT_V(8); PG8_WAIT_L(0); PG8_BAR; PG8_MMA(1, 0, At, B0); PG8_MMA(1, 1, At, B1); PG8_BAR; PG8_SCHED;
            PG8_LDB(B0, 1, 0); PG8_LDB(B1, 1, 1); PG8_SCHED; PG8_LDA(At, 1, 0); PG8_STAGE(PG8_SA(0, 1), a2 + hstepA, voffA);
            PG8_WAIT_V(8); PG8_WAIT_L(0); PG8_BAR; PG8_MMA(0, 0, At, B0); PG8_MMA(0, 1, At, B1); PG8_BAR; PG8_SCHED;
            PG8_LDA(At, 1, 1); PG8_STAGE(PG8_SB(1, 0), b3, voffB); PG8_STAGE(PG8_SB(1, 1), b3 + hstepB, voffB); PG8_STAGE(PG8_SA(1, 0), a3, voffA);
            PG8_WAIT_V(8); PG8_WAIT_L(0); PG8_BAR; PG8_MMA(1, 0, At, B0); PG8_MMA(1, 1, At, B1); PG8_BAR; PG8_SCHED;
            } else {
            PG8_LDB(B0, 0, 0); PG8_SCHED; PG8_LDA(At, 0, 0); PG8_STAGE(PG8_SA(1, 1), a1 + hstepA, voffA);
            PG8_WAIT_L(8); PG8_BAR; PG8_WAIT_L(0); PG8_MMA(0, 0, At, B0); PG8_BAR; PG8_SCHED;
            PG8_LDB(B1, 0, 1); PG8_STAGE(PG8_SB(0, 0), b2, voffB);
            PG8_BAR; PG8_WAIT_L(0); PG8_MMA(0, 1, At, B1); PG8_BAR;
            PG8_LDA(At, 0, 1); PG8_STAGE(PG8_SA(0, 0), a2, voffA);
            PG8_BAR; PG8_WAIT_L(0); PG8_MMA(1, 0, At, B0); PG8_BAR; PG8_SCHED;
            PG8_STAGE(PG8_SB(0, 1), b2 + hstepB, voffB);
            PG8_WAIT_V(6); PG8_BAR; PG8_MMA(1, 1, At, B1); PG8_BAR;
            PG8_LDB(B0, 1, 0); PG8_SCHED; PG8_LDA(At, 1, 0); PG8_STAGE(PG8_SA(0, 1), a2 + hstepA, voffA);
            PG8_WAIT_L(8); PG8_BAR; PG8_WAIT_L(0); PG8_MMA(0, 0, At, B0); PG8_BAR; PG8_SCHED;
            PG8_LDB(B1, 1, 1); PG8_STAGE(PG8_SB(1, 0), b3, voffB);
            PG8_BAR; PG8_WAIT_L(0); PG8_MMA(0, 1, At, B1); PG8_BAR;
            PG8_LDA(At, 1, 1); PG8_STAGE(PG8_SA(1, 0), a3, voffA);
            PG8_BAR; PG8_WAIT_L(0); PG8_MMA(1, 0, At, B0); PG8_BAR; PG8_SCHED;
            PG8_STAGE(PG8_SB(1, 1), b3 + hstepB, voffB);
            PG8_WAIT_V(6); PG8_BAR; PG8_MMA(1, 1, At, B1); PG8_BAR;
            }
        }
        if constexpr (ALIGN_EPI) { if (wr == 0) PG8_BAR; }
        E(acc, cur, wr, wc, fr, fq); S.done(cur);
        if (!has_next) break;
#pragma unroll
        for (int a = 0; a < 2; ++a)
#pragma unroll
            for (int b = 0; b < 2; ++b)
#pragma unroll
                for (int m = 0; m < 4; ++m)
#pragma unroll
                    for (int n = 0; n < 2; ++n) acc[a][b][m][n] = (f32x4){0.f, 0.f, 0.f, 0.f};
        cur = nxt; cA = nA; cB = nB; ++ui;
        if constexpr (ALIGN_EPI) { if (wr == 1) PG8_BAR; }
    }
    PG8_WAIT_V(0);
    if constexpr (!ALIGN_EPI) { if (wr == 0) PG8_BAR; }
    PG8_BAR;
#undef PG8_SA
#undef PG8_SB
#undef PG8_STAGE
#undef PG8_LDA
#undef PG8_LDB
#undef PG8_MMA
#undef PG8_WAIT_V
#undef PG8_WAIT_L
#undef PG8_BAR
#undef PG8_SCHED
}
}

#define XB_TMO      128
#define XB_XCNT(j)  (256  + 64 * (j))
#define XB_XSUB(j)  (1280 + 64 * (j))
#define XB_XGEN(j)  (2304 + 64 * (j))
#define XB_TOP      3328
#define XB_TOPGEN   3392
#define XCD_BAR_WORDS 3456
#define XB_SPIN_CAP (1u << 18)
__device__ __forceinline__ unsigned xb_ld(unsigned* p)              { return __hip_atomic_load(p, __ATOMIC_RELAXED, __HIP_MEMORY_SCOPE_AGENT); }
__device__ __forceinline__ unsigned xb_add(unsigned* p, unsigned v) { return __hip_atomic_fetch_add(p, v, __ATOMIC_RELAXED, __HIP_MEMORY_SCOPE_AGENT); }
__device__ __forceinline__ unsigned xb_xcc_id() { return (unsigned)__builtin_amdgcn_s_getreg((3 << 11) | 20) & 0xFu; }
#define XB_SPIN(cond, bar) do { unsigned _sp = 0; while (cond) { __builtin_amdgcn_s_sleep(1); \
    if ((++_sp & 255u) == 0u) { if (xb_ld(&(bar)[XB_TMO])) break; if (_sp > XB_SPIN_CAP) { atomicAdd(&(bar)[XB_TMO], 1u); break; } } } } while (0)
struct XcdBarrier { unsigned* bar; unsigned x; volatile LAS unsigned* st; };
__device__ __forceinline__ XcdBarrier xcd_barrier_post(unsigned* bar, volatile LAS unsigned* st) {
    XcdBarrier b; b.bar = bar; b.x = xb_xcc_id(); b.st = st;
    if (threadIdx.x == 0) (void)xb_add(&bar[XB_XCNT(b.x)], 1u);
    return b;
}
__device__ __forceinline__ void xcd_barrier_complete(unsigned* bar, unsigned x, unsigned& nloc, unsigned& nx) {
    const unsigned G = gridDim.x * gridDim.y * gridDim.z;
    unsigned sum, cnt, mine, sp = 0u;
    for (;;) {
        sum = 0u; cnt = 0u; mine = 0u;
#pragma unroll
        for (unsigned j = 0; j < 16; ++j) { const unsigned c = xb_ld(&bar[XB_XCNT(j)]); sum += c; cnt += (c > 0u) ? 1u : 0u; mine = (j == x) ? c : mine; }
        if (sum == G) break;
        __builtin_amdgcn_s_sleep(1);
        if ((++sp & 255u) == 0u) { if (xb_ld(&bar[XB_TMO])) break; if (sp > XB_SPIN_CAP) { atomicAdd(&bar[XB_TMO], 1u); break; } }
    }
    nloc = mine > 0u ? mine : 1u; nx = cnt > 0u ? cnt : 1u;
}
__device__ __forceinline__ void xcd_barrier(const XcdBarrier& b) {
    asm volatile("s_waitcnt vmcnt(0)" ::: "memory");
    __syncthreads();
    if (threadIdx.x == 0) {
        unsigned* bar = b.bar;
        __builtin_amdgcn_s_waitcnt(0);
        unsigned nloc = b.st[0], nx = b.st[1];
        if (nloc == 0u) { xcd_barrier_complete(bar, b.x, nloc, nx); b.st[0] = nloc; b.st[1] = nx; }
        const unsigned old = xb_add(&bar[XB_XSUB(b.x)], 1u);
        const unsigned gen = old / nloc;
        if (old + 1u == (gen + 1u) * nloc) {
            __builtin_amdgcn_fence(__ATOMIC_RELEASE, "agent");
            asm volatile("s_waitcnt vmcnt(0)" ::: "memory");
            const unsigned og = xb_add(&bar[XB_TOP], 1u);
            const unsigned tg = og / nx;
            if (og + 1u == (tg + 1u) * nx) xb_add(&bar[XB_TOPGEN], 1u);
            else XB_SPIN(xb_ld(&bar[XB_TOPGEN]) == tg, bar);
            __builtin_amdgcn_fence(__ATOMIC_ACQUIRE, "agent");
            xb_add(&bar[XB_XGEN(b.x)], 1u);
            asm volatile("s_waitcnt vmcnt(0)" ::: "memory");
        } else {
            XB_SPIN(xb_ld(&bar[XB_XGEN(b.x)]) == gen, bar);
            __builtin_amdgcn_fence(__ATOMIC_ACQUIRE, "agent");
            asm volatile("s_waitcnt vmcnt(0)" ::: "memory");
        }
    }
    __syncthreads();
}

struct Args { const float* in[N_IN]; float* out; unsigned char* ws; int ph_lo, ph_hi; };
struct Frame {
    LAS unsigned char* lds;
    unsigned* ctl;
    int tid, lane, wave, G, gw, NGW;
    const float* const* in; float* out; unsigned char* ws;
};
__device__ __forceinline__ void row_info(int m, int& bq, int& t, int& pos) {
    if (m < MP) { bq = m >> 11; t = m & 2047; pos = t; } else { const int s = m - MP; bq = NB_P + (s >> 3); t = s & 7; pos = PAST + t; }
}
__device__ __forceinline__ int seq_row0(int bq) { return bq < NB_P ? bq * SEQ : MP + (bq - NB_P) * DSEQ; }
__device__ __forceinline__ size_t kwin_row0(int bq) { return bq < NB_P ? (size_t)bq * SEQ : (size_t)MP + (size_t)(bq - NB_P) * WLEN_S; }
__device__ __forceinline__ size_t vwint_base(int bq, int g, int& len) {
    if (bq < NB_P) { len = SEQ; return ((size_t)bq * 2 + g) * 64 * SEQ; }
    len = WLEN_S; return (size_t)NB_P * 2 * 64 * SEQ + ((size_t)(bq - NB_P) * 2 + g) * 64 * WLEN_S;
}

__device__ __forceinline__ void transpose_item(const float* W, int K, int N, int Npad, bf16* WT, int ldt, int grp, int gstride, int off, LAS float* scr, int item, int lane) {
    const int nblk = Npad / 32, kb = item / nblk, nb = item % nblk, k0 = 64 * kb, n0 = 32 * nb;
    const int nn = n0 + (lane & 31);
#pragma unroll 8
    for (int i = 0; i < 32; ++i) { const int kk = 2 * i + (lane >> 5); scr[kk * 33 + (lane & 31)] = (nn < N) ? W[(size_t)(k0 + kk) * N + nn] : 0.f; }
    LDS_WAIT(); asm volatile("" ::: "memory");
    const int c = lane & 7;
    const int drow0 = (n0 / grp) * gstride + (n0 % grp) + off;
#pragma unroll
    for (int j = 0; j < 4; ++j) { const int n = (lane >> 3) + 8 * j; const LAS float* s = scr + (8 * c) * 33 + n;
        u32x4 o; o.x = pk2(s[0 * 33], s[1 * 33]); o.y = pk2(s[2 * 33], s[3 * 33]); o.z = pk2(s[4 * 33], s[5 * 33]); o.w = pk2(s[6 * 33], s[7 * 33]);
        *(u32x4*)(WT + (size_t)(drow0 + n) * ldt + k0 + 8 * c) = o; }
    LDS_WAIT(); asm volatile("" ::: "memory");
}
constexpr int TI_WA = 16 * 80, TI_SQ = 16 * 32, TI_CMP = 32 * 2, TI_WG = 4 * 8, TI_W13 = 16 * 88, TI_W2 = 44 * 32;
constexpr int TI_TOTAL = 2 * TI_WA + 2 * TI_SQ + 4 * TI_CMP + 4 * TI_SQ + 8 * TI_WG + 8 * TI_W13 + 4 * TI_W2;
__device__ __forceinline__ void p0_weights(Frame& F) {
    LAS float* scr = (LAS float*)(F.lds + F.wave * 16384);
    unsigned char* ws = F.ws;
    for (int it = F.gw; it < TI_TOTAL; it += F.NGW) {
        int r = it;
        if (r < 2 * TI_WA) { const int ia = r / TI_WA; transpose_item(F.in[I_WINA] + (size_t)ia * DM * IN_A, DM, IN_A, IN_A_PAD, (bf16*)(ws + WS_WA) + (size_t)ia * IN_A_PAD * DM, DM, 1 << 20, 0, 0, scr, r % TI_WA, F.lane); continue; } r -= 2 * TI_WA;
        if (r < 2 * TI_SQ) { const int ia = r / TI_SQ; transpose_item(F.in[I_WOUTA] + (size_t)ia * DM * DM, DM, DM, DM, (bf16*)(ws + WS_WO) + (size_t)ia * DM * DM, DM, 1 << 20, 0, 0, scr, r % TI_SQ, F.lane); continue; } r -= 2 * TI_SQ;
        if (r < 4 * TI_CMP) { const int q = r / TI_CMP, ia = q >> 1, kv = q & 1; transpose_item(F.in[kv ? I_WCV : I_WCK] + (size_t)ia * 2048 * 64, 2048, 64, 64, (bf16*)(ws + WS_WCMP) + (size_t)q * 64 * 2048, 2048, 1 << 20, 0, 0, scr, r % TI_CMP, F.lane); continue; } r -= 4 * TI_CMP;
        if (r < 2 * TI_SQ) { const int ic = r / TI_SQ; transpose_item(F.in[I_WINC] + (size_t)ic * DM * DM, DM, DM, DM, (bf16*)(ws + WS_WCIN) + (size_t)ic * DM * DM, DM, 1 << 20, 0, 0, scr, r % TI_SQ, F.lane); continue; } r -= 2 * TI_SQ;
        if (r < 2 * TI_SQ) { const int ic = r / TI_SQ; transpose_item(F.in[I_WOUTC] + (size_t)ic * DM * DM, DM, DM, DM, (bf16*)(ws + WS_WCOUT) + (size_t)ic * DM * DM, DM, 1 << 20, 0, 0, scr, r % TI_SQ, F.lane); continue; } r -= 2 * TI_SQ;
        if (r < 8 * TI_WG) { const int q = r / TI_WG; transpose_item(F.in[I_WGRP] + (size_t)q * 256 * 256, 256, 256, 256, (bf16*)(ws + WS_WG) + (size_t)(q >> 2) * DM * DM + (size_t)(q & 3) * 256 * (DM + 1), DM, 1 << 20, 0, 0, scr, r % TI_WG, F.lane); continue; } r -= 8 * TI_WG;
        if (r < 8 * TI_W13) { const int q = r / TI_W13, l = q >> 1, w3 = q & 1; transpose_item(F.in[w3 ? I_W3 : I_W1] + (size_t)l * DM * DFF, DM, DFF, DFF, (bf16*)(ws + WS_W13) + (size_t)l * 2 * DFF * DM, DM, 128, 256, w3 * 128, scr, r % TI_W13, F.lane); continue; } r -= 8 * TI_W13;
        { const int l = r / TI_W2; transpose_item(F.in[I_W2] + (size_t)l * DFF * DM, DFF, DM, DM, (bf16*)(ws + WS_W2) + (size_t)l * DM * DFF, DFF, 1 << 20, 0, 0, scr, r % TI_W2, F.lane); }
    }
}
__device__ __forceinline__ void p0_misc(Frame& F) {
    unsigned char* ws = F.ws;
    float* XF = (float*)(ws + WS_XF); bf16* XB = (bf16*)(ws + WS_XB);
    for (int m = F.gw; m < M; m += F.NGW) {
        const float* src = (m < MP) ? F.in[I_XP] + (size_t)m * DM : F.in[I_XS] + (size_t)(m - MP) * DM;
#pragma unroll
        for (int j = 0; j < 4; ++j) { const f32x4 v = *((const f32x4*)src + F.lane + 64 * j); *((f32x4*)(XF + (size_t)m * DM) + F.lane + 64 * j) = v;
            u32x2 w; w.x = pk2(v[0], v[1]); w.y = pk2(v[2], v[3]); *((u32x2*)(XB + (size_t)m * DM) + F.lane + 64 * j) = w; }
    }
    float* rope = (float*)(ws + WS_ROPE);
    for (int e = F.gw * 64 + F.lane; e < KLEN * 32; e += F.NGW * 64) {
        const int pos = e >> 5, i = e & 31;
        const float inv = powf(10000.0f, -(float)i / 32.0f);
        const float ang = (float)pos * inv;
        rope[2 * e] = cosf(ang); rope[2 * e + 1] = sinf(ang);
    }
    float* biasc = (float*)(ws + WS_BIASC);
    for (int o = F.gw; o < 4 * 64; o += F.NGW) {
        const int q = o >> 6, e = o & 63, ia = q >> 1, kv = q & 1;
        const float* pe = F.in[kv ? I_PECV : I_PECK] + (size_t)ia * 2048; const float* w = F.in[kv ? I_WCV : I_WCK] + (size_t)ia * 2048 * 64;
        float s = 0.f;
        for (int k = F.lane; k < 2048; k += 64) s += pe[k] * w[(size_t)k * 64 + e];
        s = wave_sum(s);
        if (F.lane == 0) biasc[o] = s;
    }
}
__device__ __forceinline__ void convert_kv_tile(const float* src, int rstride, int koff, int voff, bf16* kdst, bf16* vdst, int vlen, int slot0, LAS bf16* scr, int lane) {
#pragma unroll 4
    for (int j = 0; j < 64; j += 2) { const int tok = j + (lane >> 5), c = (lane & 31) * 4;
        const f32x4 v = *(const f32x4*)(src + (size_t)tok * rstride + koff + c);
        u32x2 w; w.x = pk2(v[0], v[1]); w.y = pk2(v[2], v[3]); *(u32x2*)(kdst + (size_t)tok * 128 + c) = w; }
    const int col = vt_col(slot0 + lane);
    for (int gh = 0; gh < 2; ++gh) {
#pragma unroll 4
        for (int j = 0; j < 64; j += 4) { const int tok = j + (lane >> 4), c = (lane & 15) * 4;
            const f32x4 v = *(const f32x4*)(src + (size_t)tok * rstride + voff + gh * 64 + c);
            LAS unsigned* p = (LAS unsigned*)(scr + tok * 66 + c); p[0] = pk2(v[0], v[1]); p[1] = pk2(v[2], v[3]); }
        LDS_WAIT(); asm volatile("" ::: "memory");
#pragma unroll 4
        for (int c = 0; c < 64; ++c) vdst[(size_t)(gh * 64 + c) * vlen + col] = scr[lane * 66 + c];
        LDS_WAIT(); asm volatile("" ::: "memory");
    }
}
template <class RowPtr>
__device__ __forceinline__ void compress_task(const RowPtr& rowptr, const bf16* WT  , const float* bias  , const float* rope, int kv, int half, bf16* kcmp_row0  , bf16* vcmpt_gd0  , int lane) {
    const int r = lane & 31, h = lane >> 5, n = 32 * half + r;
    f32x16 acc0 = {}, acc1 = {};
    for (int p = 0; p < 32; ++p) {
        const float* src = rowptr(n, p);
        const bf16* w0 = WT + (size_t)r * 2048 + p * 64 + 8 * h;
        const bf16* w1 = w0 + (size_t)32 * 2048;
#pragma unroll
        for (int s = 0; s < 4; ++s) {
            const f32x4 a0 = *(const f32x4*)(src + 16 * s + 8 * h), a1 = *(const f32x4*)(src + 16 * s + 8 * h + 4);
            u32x4 aw; aw.x = pk2(a0[0], a0[1]); aw.y = pk2(a0[2], a0[3]); aw.z = pk2(a1[0], a1[1]); aw.w = pk2(a1[2], a1[3]);
            const bf16x8 af = __builtin_bit_cast(bf16x8, aw);
            const bf16x8 b0 = *(const bf16x8*)(w0 + 16 * s), b1 = *(const bf16x8*)(w1 + 16 * s);
            acc0 = __builtin_amdgcn_mfma_f32_32x32x16_bf16(af, b0, acc0, 0, 0, 0);
            acc1 = __builtin_amdgcn_mfma_f32_32x32x16_bf16(af, b1, acc1, 0, 0, 0);
        }
    }
    const float bi0 = bias[r], bi1 = bias[r + 32];
#pragma unroll
    for (int reg = 0; reg < 16; ++reg) {
        const int nn = 32 * half + (reg & 3) + 8 * (reg >> 2) + 4 * h;
        float x1 = acc0[reg] + bi0, x2 = acc1[reg] + bi1;
        if (kv == 0) {
            const int pos = 32 * nn + 31; const float c = rope[(pos * 32 + r) * 2], sn = rope[(pos * 32 + r) * 2 + 1];
            const float o1 = x1 * c - x2 * sn, o2 = x2 * c + x1 * sn;
            kcmp_row0[(size_t)nn * 128 + r] = f2bf(o1); kcmp_row0[(size_t)nn * 128 + r + 32] = f2bf(o2);
        } else {
            vcmpt_gd0[(size_t)r * 64 + vt_col(nn)] = f2bf(x1); vcmpt_gd0[(size_t)(r + 32) * 64 + vt_col(nn)] = f2bf(x2);
        }
    }
}
struct CacheRowPtr { const float* cache_ia; const int* pt_b; int slot_off;
    __device__ __forceinline__ const float* operator()(int n, int p) const { const int page = pt_b[n >> 2]; return cache_ia + ((size_t)page * PAGE + (n & 3) * 32 + p) * 512 + slot_off; } };
struct KvOutRowPtr { const float* base; int slot_off;
    __device__ __forceinline__ const float* operator()(int n, int p) const { return base + (size_t)(32 * n + p) * 512 + slot_off; } };

__device__ __forceinline__ void p0_sample_state(Frame& F) {
    unsigned char* ws = F.ws;
    LAS bf16* scr = (LAS bf16*)(F.lds + F.wave * 8448);
    const int* pt = (const int*)F.in[I_PT];
    for (int it = F.gw; it < 2 * NB_S * 32; it += F.NGW) {
        const int ia = it / (NB_S * 32), rem = it % (NB_S * 32), b = rem >> 5, tt = rem & 31, bq = NB_P + b;
        const int page = pt[b * NPAGES + (tt >> 1)];
        const float* src = F.in[I_CACHE] + (((size_t)ia * NPOOLPG + page) * PAGE + (tt & 1) * 64) * 512;
        bf16* kdst = (bf16*)(ws + WS_KSEL) + ia * KSEL_L + ((size_t)bq * KLEN + 64 * tt) * 128;
        bf16* vdst = (bf16*)(ws + WS_VSELT) + ia * KSEL_L + (size_t)bq * 2 * 64 * KLEN;
        convert_kv_tile(src, 512, 256, 384, kdst, vdst, KLEN, 64 * tt, scr, F.lane);
    }
    for (int it = F.gw; it < 2 * NB_S * 8; it += F.NGW) {
        const int ia = it / (NB_S * 8), rem = it % (NB_S * 8), b = rem >> 3, tt = rem & 7, bq = NB_P + b;
        const float* src = F.in[I_SWIN] + (((size_t)ia * NB_S + b) * WB + 64 * tt) * 256;
        bf16* kdst = (bf16*)(ws + WS_KWIN) + ia * KWIN_L + (kwin_row0(bq) + 64 * tt) * 128;
        int vlen; const size_t vb = vwint_base(bq, 0, vlen);
        bf16* vdst = (bf16*)(ws + WS_VWINT) + ia * KWIN_L + vb;
        convert_kv_tile(src, 256, 0, 128, kdst, vdst, vlen, 64 * tt, scr, F.lane);
        float* wout = F.out + O_WINS + ((size_t)ia * NB_S + b) * WB * 256;
        for (int j = 0; j < 64; ++j) { const int row = 64 * tt + j; if (row >= 8) *((f32x4*)(wout + (size_t)(row - 8) * 256) + F.lane) = *((const f32x4*)(src + (size_t)j * 256) + F.lane); }
    }
    for (int it = F.gw; it < 2 * NB_S * 8; it += F.NGW) {
        const int ia = it / (NB_S * 8), rem = it % (NB_S * 8), b = rem >> 3, kv = (rem >> 2) & 1, g = (rem >> 1) & 1, half = rem & 1, bq = NB_P + b;
        CacheRowPtr rp{F.in[I_CACHE] + (size_t)ia * NPOOLPG * PAGE * 512, pt + b * NPAGES, kv * 128 + g * 64};
        compress_task(rp, (const bf16*)(ws + WS_WCMP) + (size_t)(ia * 2 + kv) * 64 * 2048, (const float*)(ws + WS_BIASC) + (ia * 2 + kv) * 64, (const float*)(ws + WS_ROPE), kv, half,
                      (bf16*)(ws + WS_KCMP) + ia * KCMP_L + (size_t)bq * 64 * 128 + g * 64, (bf16*)(ws + WS_VCMPT) + ia * KCMP_L + ((size_t)bq * 2 + g) * 64 * 64, F.lane);
    }
    for (int it = F.gw; it < 2 * NB_S * 22; it += F.NGW) {
        const int q = it / 22, j = it % 22;
        const float* src = F.in[I_SCONV] + ((size_t)q * 30 + 8 + j) * CB; float* dst = F.out + O_CONVS + ((size_t)q * 30 + j) * CB;
        *((f32x4*)dst + F.lane) = *((const f32x4*)src + F.lane); *((f32x4*)dst + 64 + F.lane) = *((const f32x4*)src + 64 + F.lane);
    }
    for (int it = F.gw; it < 2 * NB_S * 7; it += F.NGW) {
        const int q = it / 7, j = it % 7;
        const float* src = F.in[I_SPOOL] + ((size_t)q * PHIST + 8 + j) * DM; float* dst = F.out + O_POOLS + ((size_t)q * PHIST + j) * DM;
#pragma unroll
        for (int k = 0; k < 4; ++k) *((f32x4*)dst + 64 * k + F.lane) = *((const f32x4*)src + 64 * k + F.lane);
    }
}

__device__ __forceinline__ void a1_post(Frame& F, int ia) {
    unsigned char* ws = F.ws;
    const float* H = (const float*)(ws + WS_H); const float* rope = (const float*)(ws + WS_ROPE);
    bf16* Q = (bf16*)(ws + WS_Q);
    bf16* KSEL = (bf16*)(ws + WS_KSEL) + ia * KSEL_L; bf16* VSELT = (bf16*)(ws + WS_VSELT) + ia * KSEL_L;
    bf16* KWIN = (bf16*)(ws + WS_KWIN) + ia * KWIN_L; bf16* VWINT = (bf16*)(ws + WS_VWINT) + ia * KWIN_L;
    float* GATES = (float*)(ws + WS_GATES); float* U = (float*)(ws + WS_U);
    const int l = F.lane;
    for (int m = F.gw; m < M; m += F.NGW) {
        int bq, t, pos; row_info(m, bq, t, pos);
        const float* h = H + (size_t)m * IN_A_PAD;
        const bool prm = m < MP;
        float* kvo = prm ? F.out + O_KVP + ((size_t)ia * MP + m) * 512 : F.out + O_KVS + ((size_t)ia * MS + (m - MP)) * 512;
        const int i = l & 31; const float cs = rope[(pos * 32 + i) * 2], sn = rope[(pos * 32 + i) * 2 + 1];
#pragma unroll
        for (int k = 0; k < 4; ++k) { const int hh = (l >> 5) + 2 * k; const float x1 = h[hh * 64 + i], x2 = h[hh * 64 + i + 32];
            Q[(size_t)m * 512 + hh * 64 + i] = f2bf((x1 * cs - x2 * sn) * C2); Q[(size_t)m * 512 + hh * 64 + i + 32] = f2bf((x2 * cs + x1 * sn) * C2); }
        kvo[l] = h[512 + l]; kvo[l + 64] = h[512 + 64 + l]; kvo[128 + l] = h[640 + l]; kvo[128 + 64 + l] = h[640 + 64 + l];
        const int g = l >> 5;
        { const float x1 = h[768 + g * 64 + i], x2 = h[768 + g * 64 + i + 32]; const float o1 = x1 * cs - x2 * sn, o2 = x2 * cs + x1 * sn;
          kvo[256 + g * 64 + i] = o1; kvo[256 + g * 64 + i + 32] = o2;
          bf16* kr = KSEL + ((size_t)bq * KLEN + pos) * 128 + g * 64 + i; kr[0] = f2bf(o1); kr[32] = f2bf(o2); }
#pragma unroll
        for (int k = 0; k < 2; ++k) { const int idx = l + 64 * k; const float v = h[896 + idx]; kvo[384 + idx] = v;
            VSELT[((size_t)bq * 2 * 64 + idx) * KLEN + vt_col(pos)] = f2bf(v); }
        const int wi = prm ? pos : pos - 1536;
        float* wo = nullptr;
        if (prm) { if (t >= SEQ - WB) wo = F.out + O_WINP + (((size_t)ia * NB_P + bq) * WB + (t - (SEQ - WB))) * 256; }
        else wo = F.out + O_WINS + (((size_t)ia * NB_S + (bq - NB_P)) * WB + (WB - DSEQ) + t) * 256;
        { const float x1 = h[1024 + g * 64 + i], x2 = h[1024 + g * 64 + i + 32]; const float o1 = x1 * cs - x2 * sn, o2 = x2 * cs + x1 * sn;
          bf16* kr = KWIN + (kwin_row0(bq) + wi) * 128 + g * 64 + i; kr[0] = f2bf(o1); kr[32] = f2bf(o2);
          if (wo) { wo[g * 64 + i] = o1; wo[g * 64 + i + 32] = o2; } }
#pragma unroll
        for (int k = 0; k < 2; ++k) { const int idx = l + 64 * k; const float v = h[1152 + idx];
            int vlen; const size_t vb = vwint_base(bq, idx >> 6, vlen);
            VWINT[vb + (size_t)(idx & 63) * vlen + vt_col(wi)] = f2bf(v);
            if (wo) wo[128 + idx] = v; }
        if (l < 24) GATES[(size_t)m * 24 + l] = sigmoidf_(h[1280 + l]);
        float* co = nullptr;
        if (prm) { if (t >= SEQ - 30) co = F.out + O_CONVP + (((size_t)ia * NB_P + bq) * 30 + (t - (SEQ - 30))) * CB; }
        else co = F.out + O_CONVS + (((size_t)ia * NB_S + (bq - NB_P)) * 30 + 22 + t) * CB;
#pragma unroll
        for (int k = 0; k < 8; ++k) { const int ch = l + 64 * k; const float u = h[1304 + ch] * sigmoidf_(h[1816 + ch]); U[(size_t)m * CB + ch] = u; if (co) co[ch] = u; }
    }
}

__device__ __forceinline__ void a2_compress_prompt(Frame& F, int ia) {
    unsigned char* ws = F.ws;
    for (int it = F.gw; it < NB_P * 8; it += F.NGW) {
        const int b = it >> 3, kv = (it >> 2) & 1, g = (it >> 1) & 1, half = it & 1;
        KvOutRowPtr rp{F.out + O_KVP + ((size_t)ia * MP + (size_t)b * SEQ) * 512, kv * 128 + g * 64};
        compress_task(rp, (const bf16*)(ws + WS_WCMP) + (size_t)(ia * 2 + kv) * 64 * 2048, (const float*)(ws + WS_BIASC) + (ia * 2 + kv) * 64, (const float*)(ws + WS_ROPE), kv, half,
                      (bf16*)(ws + WS_KCMP) + ia * KCMP_L + (size_t)b * 64 * 128 + g * 64, (bf16*)(ws + WS_VCMPT) + ia * KCMP_L + ((size_t)b * 2 + g) * 64 * 64, F.lane);
    }
}
__device__ __forceinline__ void a2_conv(Frame& F, int ia) {
    unsigned char* ws = F.ws;
    const float* U = (const float*)(ws + WS_U); bf16* ACAT = (bf16*)(ws + WS_ACAT);
    const float* cw = F.in[I_CONVW] + (size_t)ia * CONVW * CB; const float* cbias = F.in[I_CONVB] + ia * CB;
    const float* lg = F.in[I_CLNG] + ia * CB; const float* lb = F.in[I_CLNB] + ia * CB;
    const int ch0 = 8 * F.lane;
    for (int it = F.NGW - 1 - F.gw; it < M / 8; it += F.NGW) {
        const int m0 = it * 8; int bq, t0, pos0; row_info(m0, bq, t0, pos0);
        const float* hist = (m0 >= MP) ? F.in[I_SCONV] + ((size_t)ia * NB_S + (bq - NB_P)) * 30 * CB : nullptr;
        auto ldrow = [&](int tau, f32x4& a, f32x4& b) {
            if (tau >= 0) { const float* p = U + (size_t)(m0 - t0 + tau) * CB + ch0; a = *(const f32x4*)p; b = *(const f32x4*)(p + 4); }
            else if (hist) { const float* p = hist + (size_t)(30 + tau) * CB + ch0; a = *(const f32x4*)p; b = *(const f32x4*)(p + 4); }
            else { a = (f32x4){0.f, 0.f, 0.f, 0.f}; b = a; } };
        f32x4 acc[8][2], win[8][2];
        { const f32x4 b0 = *(const f32x4*)(cbias + ch0), b1 = *(const f32x4*)(cbias + ch0 + 4);
#pragma unroll
          for (int tt = 0; tt < 8; ++tt) { acc[tt][0] = b0; acc[tt][1] = b1; } }
#pragma unroll
        for (int tt = 0; tt < 8; ++tt) ldrow(t0 + tt - 30, win[tt][0], win[tt][1]);
        for (int j = 0; j < CONVW; ++j) {
            const f32x4 w0 = *(const f32x4*)(cw + (size_t)j * CB + ch0), w1 = *(const f32x4*)(cw + (size_t)j * CB + ch0 + 4);
#pragma unroll
            for (int tt = 0; tt < 8; ++tt) { acc[tt][0] += w0 * win[tt][0]; acc[tt][1] += w1 * win[tt][1]; }
#pragma unroll
            for (int tt = 0; tt < 7; ++tt) { win[tt][0] = win[tt + 1][0]; win[tt][1] = win[tt + 1][1]; }
            if (j + 1 < CONVW) ldrow(t0 + 7 - 30 + j + 1, win[7][0], win[7][1]);
        }
        const f32x4 g0 = *(const f32x4*)(lg + ch0), g1 = *(const f32x4*)(lg + ch0 + 4), bb0 = *(const f32x4*)(lb + ch0), bb1 = *(const f32x4*)(lb + ch0 + 4);
#pragma unroll
        for (int tt = 0; tt < 8; ++tt) {
            const f32x4 a = acc[tt][0], b = acc[tt][1];
            const float mean = wave_sum((a[0] + a[1]) + (a[2] + a[3]) + (b[0] + b[1]) + (b[2] + b[3])) * (1.f / CB);
            const f32x4 da = a - mean, db = b - mean;
            const float var = wave_sum((da[0] * da[0] + da[1] * da[1]) + (da[2] * da[2] + da[3] * da[3]) + (db[0] * db[0] + db[1] * db[1]) + (db[2] * db[2] + db[3] * db[3])) * (1.f / CB);
            const float rstd = 1.0f / sqrtf(var + LN_EPS);
            f32x4 ya = da * rstd * g0 + bb0, yb = db * rstd * g1 + bb1;
#pragma unroll
            for (int k = 0; k < 4; ++k) { ya[k] = ya[k] * sigmoidf_(ya[k]); yb[k] = yb[k] * sigmoidf_(yb[k]); }
            u32x4 w; w.x = pk2(ya[0], ya[1]); w.y = pk2(ya[2], ya[3]); w.z = pk2(yb[0], yb[1]); w.w = pk2(yb[2], yb[3]);
            *(u32x4*)(ACAT + (size_t)(m0 + tt) * DM + CB + ch0) = w;
        }
    }
}

__device__ __forceinline__ bf16x8 pack8(const f32x16& p, int s) {
    u32x4 w; w.x = pk2(p[8 * s + 0], p[8 * s + 1]); w.y = pk2(p[8 * s + 2], p[8 * s + 3]); w.z = pk2(p[8 * s + 4], p[8 * s + 5]); w.w = pk2(p[8 * s + 6], p[8 * s + 7]);
    return __builtin_bit_cast(bf16x8, w);
}
__device__ __forceinline__ void qk_tile(f32x16& p0, f32x16& p1, const bf16* Krow0, const bf16x8 (&qf)[4], int r32, int h) {
    const bf16* k0 = Krow0 + (size_t)r32 * 128 + 8 * h; const bf16* k1 = k0 + 32 * 128;
    p0 = (f32x16){}; p1 = (f32x16){};
#pragma unroll
    for (int s = 0; s < 4; ++s) {
        const bf16x8 a0 = *(const bf16x8*)(k0 + 16 * s), a1 = *(const bf16x8*)(k1 + 16 * s);
        p0 = __builtin_amdgcn_mfma_f32_32x32x16_bf16(a0, qf[s], p0, 0, 0, 0);
        p1 = __builtin_amdgcn_mfma_f32_32x32x16_bf16(a1, qf[s], p1, 0, 0, 0);
    }
}
__device__ __forceinline__ void pv_tile(f32x16 (&o)[2], const f32x16& p0, const f32x16& p1, const bf16* Vt0, int vlen, int r32, int h) {
#pragma unroll
    for (int blk = 0; blk < 2; ++blk)
#pragma unroll
        for (int s = 0; s < 2; ++s) {
            const bf16x8 pf = pack8(blk ? p1 : p0, s);
#pragma unroll
            for (int db = 0; db < 2; ++db) {
                const bf16x8 vf = *(const bf16x8*)(Vt0 + (size_t)(32 * db + r32) * vlen + 32 * blk + 16 * s + 8 * h);
                o[db] = __builtin_amdgcn_mfma_f32_32x32x16_bf16(vf, pf, o[db], 0, 0, 0);
            }
        }
}
__device__ __forceinline__ void softmax_step(f32x16& p0, f32x16& p1, float& mrun, float& lrun, f32x16 (&o)[2], int lo, int hi) {
    float tm = NEG_BIG;
#pragma unroll
    for (int reg = 0; reg < 16; ++reg) {
        const int c0 = (reg & 3) + 8 * (reg >> 2), c1 = c0 + 32;
        const bool ok0 = (c0 >= lo) & (c0 <= hi), ok1 = (c1 >= lo) & (c1 <= hi);
        p0[reg] = ok0 ? p0[reg] : NEG_BIG; p1[reg] = ok1 ? p1[reg] : NEG_BIG;
        tm = fmaxf(tm, fmaxf(p0[reg], p1[reg]));
    }
    tm = fmaxf(tm, __shfl_xor(tm, 32));
    const float mnew = fmaxf(mrun, tm);
    const float alpha = __builtin_amdgcn_exp2f(mrun - mnew);
    float ls = 0.f;
#pragma unroll
    for (int reg = 0; reg < 16; ++reg) {
        const float x0 = __builtin_amdgcn_exp2f(p0[reg] - mnew), x1 = __builtin_amdgcn_exp2f(p1[reg] - mnew);
        const float e0 = (p0[reg] > 0.5f * NEG_BIG) ? x0 : 0.f, e1 = (p1[reg] > 0.5f * NEG_BIG) ? x1 : 0.f;
        p0[reg] = e0; p1[reg] = e1; ls += e0 + e1;
    }
    lrun = lrun * alpha + ls; mrun = mnew;
#pragma unroll
    for (int reg = 0; reg < 16; ++reg) { o[0][reg] *= alpha; o[1][reg] *= alpha; }
}
__device__ __forceinline__ int crow16(int reg, int h) { return (reg & 3) + 8 * (reg >> 2) + 4 * h; }

__device__ __forceinline__ void attn_task(Frame& F, int ia, int bq, int g, int tg) {
    unsigned char* ws = F.ws;
    const int lane = F.lane, r32 = lane & 31, h = lane >> 5, tq = r32 >> 2, rh = r32 & 3, head = g * 4 + rh;
    const bool prm = bq < NB_P;
    const int t = tg * 8 + tq, m = seq_row0(bq) + t, pos = (prm ? 0 : PAST) + t;
    const bf16* Q = (const bf16*)(ws + WS_Q) + (size_t)m * 512 + head * 64 + 8 * h;
    bf16x8 qf[4];
#pragma unroll
    for (int s = 0; s < 4; ++s) qf[s] = *(const bf16x8*)(Q + 16 * s);
    const float* gt = (const float*)(ws + WS_GATES) + (size_t)m * 24 + head * 3;
    const float gc = gt[0], gs = gt[1], gw = gt[2];
    f32x16 o[2]; f32x16 p0, p1;
    LAS float* park = (LAS float*)(F.lds + F.wave * 8192) + lane;

    unsigned selmask;
    {
        const bf16* Kc = (const bf16*)(ws + WS_KCMP) + ia * KCMP_L + (size_t)bq * 64 * 128 + g * 64;
        qk_tile(p0, p1, Kc, qf, r32, h);
        const int nvalid = min((pos + 1) >> 5, 64);
        float mx = NEG_BIG;
#pragma unroll
        for (int reg = 0; reg < 16; ++reg) { const int n0 = crow16(reg, h); p0[reg] = (n0 < nvalid) ? p0[reg] : NEG_BIG; p1[reg] = (n0 + 32 < nvalid) ? p1[reg] : NEG_BIG; mx = fmaxf(mx, fmaxf(p0[reg], p1[reg])); }
        mx = fmaxf(mx, __shfl_xor(mx, 32));
        float ls = 0.f;
#pragma unroll
        for (int reg = 0; reg < 16; ++reg) {
            const float x0 = __builtin_amdgcn_exp2f(p0[reg] - mx), x1 = __builtin_amdgcn_exp2f(p1[reg] - mx);
            const float e0 = (p0[reg] > 0.5f * NEG_BIG) ? x0 : 0.f, e1 = (p1[reg] > 0.5f * NEG_BIG) ? x1 : 0.f;
            p0[reg] = e0; p1[reg] = e1; ls += e0 + e1;
        }
        ls += __shfl_xor(ls, 32);
        const float inv = ls > 0.f ? 1.0f / ls : 0.f;
#pragma unroll
        for (int reg = 0; reg < 16; ++reg) { p0[reg] *= inv; p1[reg] *= inv; }
        float own[2][4][2], oth[2][4][2];
#pragma unroll
        for (int q = 0; q < 4; ++q)
#pragma unroll
            for (int e = 0; e < 2; ++e) {
                float v0 = p0[4 * q + 2 * e] + p0[4 * q + 2 * e + 1], v1 = p1[4 * q + 2 * e] + p1[4 * q + 2 * e + 1];
                v0 += __shfl_xor(v0, 1); v0 += __shfl_xor(v0, 2); v1 += __shfl_xor(v1, 1); v1 += __shfl_xor(v1, 2);
                own[0][q][e] = v0; own[1][q][e] = v1; oth[0][q][e] = __shfl_xor(v0, 32); oth[1][q][e] = __shfl_xor(v1, 32);
            }
        float imp[32];
#pragma unroll
        for (int blk = 0; blk < 2; ++blk)
#pragma unroll
            for (int q = 0; q < 4; ++q)
#pragma unroll
                for (int hh = 0; hh < 2; ++hh)
#pragma unroll
                    for (int e = 0; e < 2; ++e) imp[16 * blk + 4 * q + 2 * hh + e] = (h == hh) ? own[blk][q][e] : oth[blk][q][e];
        const int cur = prm ? (pos >> 6) : 32;
        const int jmax = prm ? cur - 2 : 30;
        const int nfree = 8 - min(cur + 1, 3);
        imp[0] = -1.f;
#pragma unroll
        for (int j = 1; j < 32; ++j) imp[j] = (j <= jmax) ? imp[j] : -1.f;
        unsigned part = 0u;
        const int rounds = min(nfree, max(jmax, 0));
        for (int rd = 0; rd < 7; ++rd) {
            if (!__any(rd < rounds)) break;
            float mxv = imp[1];
#pragma unroll
            for (int j = 2; j < 32; ++j) mxv = fmaxf(mxv, imp[j]);
            bool found = !(rd < rounds) || !(mxv >= 0.f);
#pragma unroll
            for (int j = 1; j < 32; ++j) { const bool hit = !found && (imp[j] == mxv); found = found || hit; imp[j] = hit ? -1.f : imp[j]; part |= hit ? (1u << j) : 0u; }
        }
        selmask = part | 1u;
        if (prm) { selmask |= 1u << cur; if (cur >= 1) selmask |= 1u << (cur - 1); } else selmask |= 1u << 31;
        o[0] = (f32x16){}; o[1] = (f32x16){};
        const bf16* Vc = (const bf16*)(ws + WS_VCMPT) + ia * KCMP_L + ((size_t)bq * 2 + g) * 64 * 64;
        pv_tile(o, p0, p1, Vc, 64, r32, h);
#pragma unroll
        for (int reg = 0; reg < 16; ++reg) { park[reg * 64] = gc * o[0][reg]; park[(16 + reg) * 64] = gc * o[1][reg]; }
    }
    {
        const bf16* Ks = (const bf16*)(ws + WS_KSEL) + ia * KSEL_L + (size_t)bq * KLEN * 128 + g * 64;
        const bf16* Vs = (const bf16*)(ws + WS_VSELT) + ia * KSEL_L + ((size_t)bq * 2 + g) * 64 * KLEN;
        float mrun = NEG_BIG, lrun = 0.f; o[0] = (f32x16){}; o[1] = (f32x16){};
        const int jt_end = prm ? ((tg * 8 + 7) >> 6) : 32;
        for (int jt = 0; jt <= jt_end; ++jt) {
            const bool mine = (jt < 32) ? ((selmask >> jt) & 1u) != 0u : true;
            if (!__any(mine)) continue;
            qk_tile(p0, p1, Ks + (size_t)jt * 64 * 128, qf, r32, h);
            const int kbase = 64 * jt + 4 * h;
            softmax_step(p0, p1, mrun, lrun, o, -1000, mine ? pos - kbase : -1);
            pv_tile(o, p0, p1, Vs + 64 * jt, KLEN, r32, h);
        }
        lrun += __shfl_xor(lrun, 32);
        const float sc = lrun > 0.f ? gs / lrun : 0.f;
#pragma unroll
        for (int reg = 0; reg < 16; ++reg) { park[reg * 64] += sc * o[0][reg]; park[(16 + reg) * 64] += sc * o[1][reg]; }
    }
    {
        const int wbase = prm ? 0 : 1536;
        const int wi = pos - wbase;
        const bf16* Kw = (const bf16*)(ws + WS_KWIN) + ia * KWIN_L + kwin_row0(bq) * 128 + g * 64;
        int vlen; const size_t vb = vwint_base(bq, g, vlen);
        const bf16* Vw = (const bf16*)(ws + WS_VWINT) + ia * KWIN_L + vb;
        float mrun = NEG_BIG, lrun = 0.f; o[0] = (f32x16){}; o[1] = (f32x16){};
        const int wi_lo = (prm ? 0 : PAST - 1536) + tg * 8, wi_hi = wi_lo + 7;
        const int jt0 = max(wi_lo - (WB - 1), 0) >> 6, jt1 = wi_hi >> 6;
        for (int jt = jt0; jt <= jt1; ++jt) {
            qk_tile(p0, p1, Kw + (size_t)jt * 64 * 128, qf, r32, h);
            const int kbase = 64 * jt + 4 * h;
            softmax_step(p0, p1, mrun, lrun, o, wi - (WB - 1) - kbase, wi - kbase);
            pv_tile(o, p0, p1, Vw + 64 * jt, vlen, r32, h);
        }
        lrun += __shfl_xor(lrun, 32);
        const float sc = lrun > 0.f ? gw / lrun : 0.f;
#pragma unroll
        for (int reg = 0; reg < 16; ++reg) { o[0][reg] = park[reg * 64] + sc * o[0][reg]; o[1][reg] = park[(16 + reg) * 64] + sc * o[1][reg]; }
    }
    bf16* O = (bf16*)(ws + WS_ACAT) + (size_t)m * DM + head * 64 + 4 * h;
#pragma unroll
    for (int db = 0; db < 2; ++db)
#pragma unroll
        for (int q = 0; q < 4; ++q) { u32x2 w; w.x = pk2(o[db][4 * q], o[db][4 * q + 1]); w.y = pk2(o[db][4 * q + 2], o[db][4 * q + 3]); *(u32x2*)(O + 32 * db + 8 * q) = w; }
}
constexpr int ATT_TASKS = NB_S * 2 + NB_P * 2 * (SEQ / 8);
__device__ __forceinline__ void a3_attention(Frame& F, int ia) {
    unsigned* ctr = F.ctl + CW_ATT + 64 * ia;
    for (;;) {
        unsigned idx = 0;
        if (F.lane == 0) idx = __hip_atomic_fetch_add(ctr, 1u, __ATOMIC_RELAXED, __HIP_MEMORY_SCOPE_AGENT);
        idx = (unsigned)__builtin_amdgcn_readfirstlane((int)idx);
        if (idx >= (unsigned)ATT_TASKS) break;
        if (idx < (unsigned)(NB_S * 2)) { attn_task(F, ia, NB_P + (int)(idx >> 1), (int)(idx & 1), 0); }
        else { const int p = (int)idx - NB_S * 2; const int chunkrev = p >> 7, bg = (p >> 3) & 15, w = p & 7;
               attn_task(F, ia, bg >> 1, bg & 1, 8 * (31 - chunkrev) + (7 - w)); }
    }
}

__device__ __forceinline__ void ln_phase(Frame& F, const float* gam, const float* bet, float* dstf, bool write_xb) {
    unsigned char* ws = F.ws;
    const float* V = (const float*)(ws + WS_V); bf16* XB = (bf16*)(ws + WS_XB);
    f32x4 gv[4], bv[4];
#pragma unroll
    for (int j = 0; j < 4; ++j) { gv[j] = *((const f32x4*)gam + F.lane + 64 * j); bv[j] = *((const f32x4*)bet + F.lane + 64 * j); }
    for (int m = F.gw; m < M; m += F.NGW) {
        const f32x4* xr = (const f32x4*)(V + (size_t)m * DM) + F.lane;
        f32x4 v[4]; float s = 0.f;
#pragma unroll
        for (int j = 0; j < 4; ++j) { v[j] = xr[64 * j]; s += (v[j][0] + v[j][1]) + (v[j][2] + v[j][3]); }
        const float mean = wave_sum(s) * (1.f / DM); float s2 = 0.f;
#pragma unroll
        for (int j = 0; j < 4; ++j) { v[j] = v[j] - mean; s2 += (v[j][0] * v[j][0] + v[j][1] * v[j][1]) + (v[j][2] * v[j][2] + v[j][3] * v[j][3]); }
        const float rstd = 1.0f / sqrtf(wave_sum(s2) * (1.f / DM) + LN_EPS);
#pragma unroll
        for (int j = 0; j < 4; ++j) { const f32x4 y = v[j] * rstd * gv[j] + bv[j]; *((f32x4*)(dstf + (size_t)m * DM) + F.lane + 64 * j) = y;
            if (write_xb) { u32x2 w; w.x = pk2(y[0], y[1]); w.y = pk2(y[2], y[3]); *((u32x2*)(XB + (size_t)m * DM) + F.lane + 64 * j) = w; } }
    }
}

__device__ __forceinline__ void c2_pool(Frame& F, int ic) {
    unsigned char* ws = F.ws;
    const float* UC = (const float*)(ws + WS_UC); bf16* D = (bf16*)(ws + WS_D);
    for (int m = F.gw; m < M; m += F.NGW) {
        int bq, t, pos; row_info(m, bq, t, pos);
        const bool prm = m < MP;
        const float* hist = prm ? nullptr : F.in[I_SPOOL] + ((size_t)ic * NB_S + (bq - NB_P)) * PHIST * DM;
        float* po = nullptr;
        if (prm) { if (t >= SEQ - PHIST) po = F.out + O_POOLP + (((size_t)ic * NB_P + bq) * PHIST + (t - (SEQ - PHIST))) * DM; }
        else po = F.out + O_POOLS + (((size_t)ic * NB_S + (bq - NB_P)) * PHIST + 7 + t) * DM;
#pragma unroll
        for (int gi = 0; gi < 4; ++gi) {
            const int w = 2 << gi, ch = gi * 256 + 4 * F.lane;
            const f32x4 u0 = *(const f32x4*)(UC + (size_t)m * DM + ch);
            f32x4 s = u0;
            for (int k = 1; k < w; ++k) { const int tau = t - k;
                if (tau >= 0) s += *(const f32x4*)(UC + (size_t)(m - k) * DM + ch);
                else if (hist) s += *(const f32x4*)(hist + (size_t)(PHIST + tau) * DM + ch); }
            const float cnt = (float)min(pos + 1, w);
            const f32x4 d = s * (1.0f / cnt) - u0;
            u32x2 o; o.x = pk2(d[0], d[1]); o.y = pk2(d[2], d[3]); *(u32x2*)(D + (size_t)m * DM + ch) = o;
            if (po) *(f32x4*)(po + ch) = u0;
        }
    }
}

__global__ void __launch_bounds__(NWAVES * 64, 2) nsa_fwd(Args args) {
    extern __shared__ __attribute__((aligned(16))) unsigned char lds[];
    Frame F;
    F.lds = (LAS unsigned char*)lds;
    F.tid = threadIdx.x; F.lane = F.tid & 63; F.wave = __builtin_amdgcn_readfirstlane(F.tid >> 6);
    F.G = gridDim.x; F.gw = blockIdx.x * NWAVES + F.wave; F.NGW = F.G * NWAVES;
    F.in = args.in; F.out = args.out; F.ws = args.ws; F.ctl = (unsigned*)(args.ws + WS_CTL);
    unsigned char* ws = args.ws;
    for (int u = F.tid; u < (LDS_BYTES - LDSCTL_OFF) / 4; u += NWAVES * 64) ((LAS unsigned*)(F.lds + LDSCTL_OFF))[u] = 0u;
    __syncthreads();
#if MK_ONE_LAUNCH
    XcdBarrier bar = xcd_barrier_post(F.ctl + CW_BAR, (volatile LAS unsigned*)(F.lds + MISC_OFF) + 8);
#define GRID_BAR() xcd_barrier(bar)
#else
#define GRID_BAR() do { } while (0)
#endif
    const int lo = args.ph_lo, hi = args.ph_hi;
    int ph = 0;
#define PHASE_BEGIN if (lo <= ph && ph < hi) { { int t_ = threadIdx.x; asm volatile("" : "+v"(t_)); F.tid = t_; F.lane = t_ & 63; }
#define PHASE_END   if (ph + 1 < hi) GRID_BAR(); } ++ph;

    PHASE_BEGIN
        if PHON(0) p0_weights(F);
        if PHON(1) p0_misc(F);
        __syncthreads();
    PHASE_END
    PHASE_BEGIN
        if PHON(2) p0_sample_state(F);
        __syncthreads();
    PHASE_END

    for (int l = 0; l < 4; ++l) {
        const int half = l >> 1;
        const bool even = (l & 1) == 0;
        PHASE_BEGIN
            pg8::Gemm g{(const bf16*)(ws + WS_XB), even ? (const bf16*)(ws + WS_WA) + (size_t)half * IN_A_PAD * DM : (const bf16*)(ws + WS_WCIN) + (size_t)half * DM * DM, M, even ? IN_A_PAD : DM, DM, DM, DM, 0};
            pg8::StaticOrder S; S.init(M, g.N, F.G, (int)blockIdx.x);
            pg8::EpiF32 E{even ? (float*)(ws + WS_H) : (float*)(ws + WS_UC), even ? IN_A_PAD : DM};
            if PHON(3) pg8::gemm_phase<pg8::EpiF32, pg8::StaticOrder, true, true>(F.lds, g, S, E);
        PHASE_END
        if (even) {
            PHASE_BEGIN if PHON(4) a1_post(F, half); PHASE_END
            PHASE_BEGIN if PHON(5) a2_compress_prompt(F, half); if PHON(6) a2_conv(F, half); PHASE_END
            PHASE_BEGIN if PHON(7) a3_attention(F, half); PHASE_END
        } else {
            PHASE_BEGIN if PHON(8) c2_pool(F, half); PHASE_END
            PHASE_BEGIN
                pg8::Gemm g{(const bf16*)(ws + WS_D), (const bf16*)(ws + WS_WG) + (size_t)half * DM * DM, M, DM, 256, DM, DM, 512};
                pg8::StaticOrder S; S.init(M, DM, F.G, (int)blockIdx.x);
                pg8::EpiScaleBf16 E{(bf16*)(ws + WS_Z), DM, F.in[I_SCALEC] + half * DM};
                if PHON(9) pg8::gemm_phase<pg8::EpiScaleBf16, pg8::StaticOrder, true, true>(F.lds, g, S, E);
            PHASE_END
        }
        PHASE_BEGIN
            pg8::Gemm g{even ? (const bf16*)(ws + WS_ACAT) : (const bf16*)(ws + WS_Z), even ? (const bf16*)(ws + WS_WO) + (size_t)half * DM * DM : (const bf16*)(ws + WS_WCOUT) + (size_t)half * DM * DM, M, DM, DM, DM, DM, 0};
            pg8::StaticOrder S; S.init(M, DM, F.G, (int)blockIdx.x);
            pg8::EpiRes E{(const float*)(ws + WS_XF), (float*)(ws + WS_V), ALPHA};
            if PHON(10) pg8::gemm_phase<pg8::EpiRes, pg8::StaticOrder, true, true>(F.lds, g, S, E);
        PHASE_END
        PHASE_BEGIN if PHON(11) ln_phase(F, F.in[I_LN1G] + l * DM, F.in[I_LN1B] + l * DM, (float*)(ws + WS_XF), true); PHASE_END
        PHASE_BEGIN
            pg8::Gemm g{(const bf16*)(ws + WS_XB), (const bf16*)(ws + WS_W13) + (size_t)l * 2 * DFF * DM, M, 2 * DFF, DM, DM, DM, 0};
            pg8::StaticOrder S; S.init(M, 2 * DFF, F.G, (int)blockIdx.x);
            pg8::EpiSwiglu E{(bf16*)(ws + WS_HF), DFF};
            if PHON(12) pg8::gemm_phase<pg8::EpiSwiglu, pg8::StaticOrder, true, true>(F.lds, g, S, E);
        PHASE_END
        PHASE_BEGIN
            pg8::Gemm g{(const bf16*)(ws + WS_HF), (const bf16*)(ws + WS_W2) + (size_t)l * DM * DFF, M, DM, DFF, DFF, DFF, 0};
            pg8::StaticOrder S; S.init(M, DM, F.G, (int)blockIdx.x);
            pg8::EpiRes E{(const float*)(ws + WS_XF), (float*)(ws + WS_V), ALPHA};
            if PHON(13) pg8::gemm_phase<pg8::EpiRes, pg8::StaticOrder, true, true>(F.lds, g, S, E);
        PHASE_END
        PHASE_BEGIN if PHON(14) ln_phase(F, F.in[I_LN2G] + l * DM, F.in[I_LN2B] + l * DM, l == 3 ? F.out + O_Y : (float*)(ws + WS_XF), l != 3); PHASE_END
    }
}
constexpr int N_PHASES = 2 + 2 * 9 + 2 * 8;

extern "C" void kernel_launch(void* const* d_in, const int* in_sizes, int n_in, void* d_out, int out_size, void* d_ws, size_t ws_size, hipStream_t stream) {
    static int grid = 0;
    if (grid == 0) {
        if (n_in != N_IN || (size_t)out_size != O_END || ws_size < WS_END) { fprintf(stderr, "kernel_launch: unexpected sizes n_in %d out %d ws %zu (need %zu)\n", n_in, out_size, ws_size, (size_t)WS_END); grid = -1; return; }
        int dev = 0, cus = 0, per_cu = 0;
        if (hipGetDevice(&dev) != hipSuccess || hipDeviceGetAttribute(&cus, hipDeviceAttributeMultiprocessorCount, dev) != hipSuccess) { grid = -1; return; }
        if (hipFuncSetAttribute((const void*)nsa_fwd, hipFuncAttributeMaxDynamicSharedMemorySize, LDS_BYTES) != hipSuccess) { fprintf(stderr, "kernel_launch: hipFuncSetAttribute failed\n"); grid = -1; return; }
        if (hipOccupancyMaxActiveBlocksPerMultiprocessor(&per_cu, (const void*)nsa_fwd, NWAVES * 64, LDS_BYTES) != hipSuccess || per_cu < 1) fprintf(stderr, "kernel_launch: occupancy query says %d\n", per_cu);
        (void)hipGetLastError();
        grid = cus;
    }
    if (grid < 0) return;
    (void)hipMemsetAsync((char*)d_ws + WS_CTL, 0, CTL_ZERO_BYTES, stream);
    Args a{};
    for (int i = 0; i < N_IN; ++i) a.in[i] = (const float*)d_in[i];
    a.out = (float*)d_out; a.ws = (unsigned char*)d_ws;
#if MK_ONE_LAUNCH
    a.ph_lo = 0; a.ph_hi = N_PHASES;
    hipLaunchKernelGGL(nsa_fwd, dim3(grid), dim3(NWAVES * 64), LDS_BYTES, stream, a);
#else
    for (int p = 0; p < N_PHASES; ++p) { a.ph_lo = p; a.ph_hi = p + 1; hipLaunchKernelGGL(nsa_fwd, dim3(grid), dim3(NWAVES * 64), LDS_BYTES, stream, a); }
#endif
}
```
